# Optimizing an MI355X kernel written in HIP

```python
import math, functools
import jax, jax.numpy as jnp
from jax import lax
import numpy as np

D_MODEL = 2048
BATCH = 2
SEQ = 16384
DEPTH = 2
DEC_BATCH = 16
DEC_SEQ = 16
PAST_LEN = 4096

CHUNK = 64
N_A = DEPTH // 2
N_B = DEPTH - N_A
POOL_WINDOWS = (2, 4, 8, 16)
N_POOL_GROUPS = len(POOL_WINDOWS)
POOL_GROUP = D_MODEL // N_POOL_GROUPS
POOL_HIST = max(POOL_WINDOWS) - 1
N_HEADS = 8
HEAD_DIM = 128
QK_WIDTH = N_HEADS * 2 * HEAD_DIM
V_HEAD = 2 * HEAD_DIM
V_WIDTH = N_HEADS * V_HEAD
D_FF = 5632
CONV_W = 3
ROPE_THETA = 10000.0
EPS = 1e-5
Q_BLOCK = 128

kernel_name = "yoco_pool_diffattn_streaming_encoder_step"


def _rmsnorm(x, g):
    x32 = x.astype(jnp.float32)
    y = x32 * lax.rsqrt(jnp.mean(x32 * x32, axis=-1, keepdims=True) + EPS)
    return (y * g.astype(jnp.float32)).astype(x.dtype)


def _rope(x, pos):
    half = HEAD_DIM // 2
    inv = jnp.exp(-math.log(ROPE_THETA) * jnp.arange(half, dtype=jnp.float32) / half)
    ang = pos.astype(jnp.float32)[:, None] * inv[None, :]
    cos = jnp.cos(ang)[None, :, None, None, :]
    sin = jnp.sin(ang)[None, :, None, None, :]
    x32 = x.astype(jnp.float32)
    x1, x2 = x32[..., :half], x32[..., half:]
    return jnp.concatenate([x1 * cos - x2 * sin, x2 * cos + x1 * sin], axis=-1).astype(x.dtype)


def _pool_mixer(h, hist, pos, w_g, scale):
    T = h.shape[1]
    xx = jnp.concatenate([hist.astype(h.dtype), h], axis=1)
    x32 = xx.astype(jnp.float32)
    cs = jnp.concatenate([jnp.zeros_like(x32[:, :1]), jnp.cumsum(x32, axis=1)], axis=1)
    end = cs[:, POOL_HIST + 1:]
    cur = x32[:, POOL_HIST:]
    outs = []
    for g, w in enumerate(POOL_WINDOWS):
        sl = slice(g * POOL_GROUP, (g + 1) * POOL_GROUP)
        start = cs[:, POOL_HIST + 1 - w: POOL_HIST + 1 - w + T, sl]
        cnt = jnp.minimum(pos + 1, w).astype(jnp.float32)[None, :, None]
        d = ((end[..., sl] - start) / cnt - cur[..., sl]).astype(h.dtype)
        outs.append(jnp.einsum('btc,cd->btd', d, w_g[g]))
    out = jnp.concatenate(outs, axis=-1) * scale
    return out, xx[:, -POOL_HIST:]


def _conv_ffn(h, hist, w_gate, w_up, conv_w, conv_b, w_down):
    T = h.shape[1]
    g = h @ w_gate
    gg = jnp.concatenate([hist.astype(g.dtype), g], axis=1)
    c = conv_b + gg[:, 0:T] * conv_w[0] + gg[:, 1:1 + T] * conv_w[1] + gg[:, 2:2 + T] * conv_w[2]
    a = jax.nn.silu(c) * (h @ w_up)
    return a @ w_down, gg[:, -(CONV_W - 1):]


def _shared_kv(x, pos, norm_kv, w_k, w_v):
    b, T, _ = x.shape
    hk = _rmsnorm(x, norm_kv)
    k = _rope((hk @ w_k).reshape(b, T, N_HEADS, 2, HEAD_DIM), pos)
    v = (hk @ w_v).reshape(b, T, N_HEADS, V_HEAD)
    return k, v


def _diff_attn_core(q, qpos, k, v, kpos, lam):
    s = jnp.einsum('bqhcd,bkhcd->cbhqk', q, k, preferred_element_type=jnp.float32) * (HEAD_DIM ** -0.5)
    mask = (kpos[None, :] // CHUNK) <= (qpos[:, None] // CHUNK)
    s = jnp.where(mask, s, -jnp.inf)
    p = jax.nn.softmax(s, axis=-1)
    wts = (p[0] - lam * p[1]).astype(v.dtype)
    return jnp.einsum('bhqk,bkhe->bqhe', wts, v)


def _diff_attn(h, pos, k, v, kpos, w_q, lq1, lk1, lq2, lk2, subln, w_o, lam_init):
    b, T, _ = h.shape
    q = _rope((h @ w_q).reshape(b, T, N_HEADS, 2, HEAD_DIM), pos)
    lam = (jnp.exp(jnp.sum(lq1.astype(jnp.float32) * lk1.astype(jnp.float32)))
           - jnp.exp(jnp.sum(lq2.astype(jnp.float32) * lk2.astype(jnp.float32))) + lam_init)
    if T > Q_BLOCK and T % Q_BLOCK == 0:
        nb = T // Q_BLOCK
        qb = jnp.moveaxis(q.reshape(b, nb, Q_BLOCK, N_HEADS, 2, HEAD_DIM), 1, 0)
        pb = pos.reshape(nb, Q_BLOCK)
        o = lax.map(lambda a: _diff_attn_core(a[0], a[1], k, v, kpos, lam), (qb, pb))
        o = jnp.moveaxis(o, 0, 1).reshape(b, T, N_HEADS, V_HEAD)
    else:
        o = _diff_attn_core(q, pos, k, v, kpos, lam)
    o = _rmsnorm(o, subln) * (1.0 - lam_init)
    return o.reshape(b, T, V_WIDTH) @ w_o


def _trunk(x, pos, pool_hist, ffn_hist, past_k, past_v, norm_mix, pool_w, pool_scale, norm_kv,
           w_k, w_v, w_q, lam_q1, lam_k1, lam_q2, lam_k2, subln, w_o, norm_ffn, w_gate, w_up,
           conv_w, conv_b, w_down, norm_final):
    b, T, _ = x.shape
    pool_states, ffn_states = [], []
    k_new = v_new = k_all = v_all = kpos = None
    for l in range(DEPTH):
        h = _rmsnorm(x, norm_mix[l])
        if l < N_A:
            mix, st = _pool_mixer(h, pool_hist[l], pos, pool_w[l], pool_scale[l])
            pool_states.append(st)
        else:
            if l == N_A:
                k_new, v_new = _shared_kv(x, pos, norm_kv, w_k, w_v)
                if past_k is None:
                    k_all, v_all, kpos = k_new, v_new, pos
                else:
                    P = past_k.shape[1]
                    k_all = jnp.concatenate([past_k.reshape(b, P, N_HEADS, 2, HEAD_DIM).astype(k_new.dtype), k_new], axis=1)
                    v_all = jnp.concatenate([past_v.astype(v_new.dtype), v_new], axis=1)
                    kpos = jnp.arange(P + T, dtype=jnp.int32)
            j = l - N_A
            lam_init = 0.8 - 0.6 * math.exp(-0.3 * l)
            mix = _diff_attn(h, pos, k_all, v_all, kpos, w_q[j], lam_q1[j], lam_k1[j], lam_q2[j],
                             lam_k2[j], subln[j], w_o[j], lam_init)
        x = x + mix
        h2 = _rmsnorm(x, norm_ffn[l])
        f, st = _conv_ffn(h2, ffn_hist[l], w_gate[l], w_up[l], conv_w[l], conv_b[l], w_down[l])
        ffn_states.append(st)
        x = x + f
    y = _rmsnorm(x, norm_final)
    return (y, jnp.stack(pool_states), jnp.stack(ffn_states),
            k_new.reshape(b, T, N_HEADS, 2 * HEAD_DIM), v_new)


def setup_inputs(seed: int = 0) -> dict:
    key = jax.random.key(seed)
    ks = jax.random.split(key, 30)

    def nrm(k, shape, scale=1.0):
        return jax.random.normal(k, shape, jnp.float32) * scale

    return {
        "x_prompt": nrm(ks[0], (BATCH, SEQ, D_MODEL)),
        "x_sample": nrm(ks[1], (DEC_BATCH, DEC_SEQ, D_MODEL)),
        "cache_pool": nrm(ks[2], (N_A, DEC_BATCH, POOL_HIST, D_MODEL)),
        "cache_ffn_conv": nrm(ks[3], (DEPTH, DEC_BATCH, CONV_W - 1, D_FF)),
        "cache_k": nrm(ks[4], (DEC_BATCH, PAST_LEN, N_HEADS, 2 * HEAD_DIM)),
        "cache_v": nrm(ks[5], (DEC_BATCH, PAST_LEN, N_HEADS, V_HEAD)),
        "norm_mix": 1.0 + nrm(ks[6], (DEPTH, D_MODEL), 0.05),
        "pool_w": nrm(ks[7], (N_A, N_POOL_GROUPS, POOL_GROUP, POOL_GROUP), POOL_GROUP ** -0.5),
        "pool_scale": 0.5 + nrm(ks[8], (N_A, D_MODEL), 0.1),
        "norm_kv": 1.0 + nrm(ks[9], (D_MODEL,), 0.05),
        "w_k": nrm(ks[10], (D_MODEL, QK_WIDTH), D_MODEL ** -0.5),
        "w_v": nrm(ks[11], (D_MODEL, V_WIDTH), D_MODEL ** -0.5),
        "w_q": nrm(ks[12], (N_B, D_MODEL, QK_WIDTH), D_MODEL ** -0.5),
        "lam_q1": nrm(ks[13], (N_B, HEAD_DIM), 0.1),
        "lam_k1": nrm(ks[14], (N_B, HEAD_DIM), 0.1),
        "lam_q2": nrm(ks[15], (N_B, HEAD_DIM), 0.1),
        "lam_k2": nrm(ks[16], (N_B, HEAD_DIM), 0.1),
        "subln": 1.0 + nrm(ks[17], (N_B, V_HEAD), 0.05),
        "w_o": nrm(ks[18], (N_B, V_WIDTH, D_MODEL), V_WIDTH ** -0.5),
        "norm_ffn": 1.0 + nrm(ks[19], (DEPTH, D_MODEL), 0.05),
        "w_gate": nrm(ks[20], (DEPTH, D_MODEL, D_FF), D_MODEL ** -0.5),
        "w_up": nrm(ks[21], (DEPTH, D_MODEL, D_FF), D_MODEL ** -0.5),
        "conv_w": nrm(ks[22], (DEPTH, CONV_W, D_FF), CONV_W ** -0.5),
        "conv_b": nrm(ks[23], (DEPTH, D_FF), 0.01),
        "w_down": nrm(ks[24], (DEPTH, D_FF, D_MODEL), D_FF ** -0.5),
        "norm_final": 1.0 + nrm(ks[25], (D_MODEL,), 0.05),
    }


def reference(x_prompt, x_sample, cache_pool, cache_ffn_conv, cache_k, cache_v, norm_mix, pool_w,
              pool_scale, norm_kv, w_k, w_v, w_q, lam_q1, lam_k1, lam_q2, lam_k2, subln, w_o,
              norm_ffn, w_gate, w_up, conv_w, conv_b, w_down, norm_final):
    trunk = functools.partial(
        _trunk, norm_mix=norm_mix, pool_w=pool_w, pool_scale=pool_scale, norm_kv=norm_kv,
        w_k=w_k, w_v=w_v, w_q=w_q, lam_q1=lam_q1, lam_k1=lam_k1, lam_q2=lam_q2, lam_k2=lam_k2,
        subln=subln, w_o=w_o, norm_ffn=norm_ffn, w_gate=w_gate, w_up=w_up, conv_w=conv_w,
        conv_b=conv_b, w_down=w_down, norm_final=norm_final)

    bp, tp, _ = x_prompt.shape
    pos_p = jnp.arange(tp, dtype=jnp.int32)
    pool_hist_p = jnp.zeros((N_A, bp, POOL_HIST, D_MODEL), x_prompt.dtype)
    ffn_hist_p = jnp.zeros((DEPTH, bp, CONV_W - 1, D_FF), x_prompt.dtype)
    y_prompt, pool_state_prompt, ffn_state_prompt, k_prompt, v_prompt = trunk(
        x_prompt, pos_p, pool_hist_p, ffn_hist_p, None, None)

    ts = x_sample.shape[1]
    pos_s = PAST_LEN + jnp.arange(ts, dtype=jnp.int32)
    y_sample, pool_state_sample, ffn_state_sample, k_sample, v_sample = trunk(
        x_sample, pos_s, cache_pool, cache_ffn_conv, cache_k, cache_v)

    return (y_prompt, y_sample, pool_state_prompt, pool_state_sample, ffn_state_prompt,
            ffn_state_sample, k_prompt, v_prompt, k_sample, v_sample)
```

```cpp
#include <hip/hip_runtime.h>
#include <hip/hip_bf16.h>
#include <cstdio>
#include <cstdint>

#ifndef MK_PER_PHASE
#define MK_PER_PHASE 0
#endif

constexpr int D = 2048, T = 16384, RP = 32768, RS = 256, R = RP + RS, FF = 5632, NH = 8;
constexpr int SKEYS = 4224, SPAST = 4096, SLIM = 4112;
constexpr float EPS = 1e-5f;
constexpr float LAM_INIT = 0.35550930759f;
constexpr size_t OFF_Y_P = 0, OFF_Y_S = 67108864, OFF_PS_P = 67633152, OFF_PS_S = 67694592, OFF_FS_P = 68186112, OFF_FS_S = 68231168,
                 OFF_K_P = 68591616, OFF_V_P = 135700480, OFF_K_S = 202809344, OFF_V_S = 203333632, OUT_TOTAL = 203857920;
constexpr size_t MiB = 1u << 20;
constexpr size_t WS_CTL = 0, CTL_ZERO_BYTES = 1 * MiB;
constexpr size_t SS_BYTES = 135168;
constexpr size_t WS_SS = 262144;
constexpr size_t WS_RINV0 = 1 * MiB, WS_CS = 2 * MiB, WS_WPOOL = 10 * MiB, WS_WQKV = 12 * MiB, WS_WO = 36 * MiB;
constexpr size_t WS_WG0 = 44 * MiB, WS_WU0 = 66 * MiB, WS_WD0 = 88 * MiB, WS_WG1 = 110 * MiB, WS_WU1 = 132 * MiB, WS_WD1 = 154 * MiB;
constexpr size_t WS_XA = 176 * MiB, WS_XB = 434 * MiB;
constexpr size_t WS_GB = 563 * MiB, WS_HB = 918 * MiB, WS_DB = 918 * MiB;
constexpr size_t WS_KB = 563 * MiB, WS_VB = 692 * MiB, WS_QB = 821 * MiB, WS_O0 = 950 * MiB, WS_O1 = 1079 * MiB, WS_AO = 821 * MiB;
constexpr size_t WS_KS = 1273 * MiB, WS_VS = 1537 * MiB, WS_END = 1801 * MiB;
static_assert(WS_SS + 4 * SS_BYTES <= CTL_ZERO_BYTES, "ss inside memset region");
static_assert((size_t)R * D * 4 == 258 * MiB && (size_t)R * FF * 2 <= 355 * MiB && (size_t)16 * SKEYS * D * 2 == 264 * MiB, "sizes");
constexpr int CW_BAR = 4096;
constexpr int NPHASE = 14;

constexpr int RING_OFF = 0, RING_BYTES = 131072;
constexpr int LDSCTL_OFF = RING_BYTES, MISC_OFF = LDSCTL_OFF + 320;
constexpr int LDS_BYTES = 147456;
constexpr int NWAVES = 8;

namespace pg8 {
#define PG8_LAS __attribute__((address_space(3)))
typedef unsigned short bf16_t;
typedef short bf16x8 __attribute__((ext_vector_type(8)));
typedef float f32x4 __attribute__((ext_vector_type(4)));
typedef unsigned u32x4 __attribute__((ext_vector_type(4)));
constexpr int BM = 256, BK = 64, HALF = 128, HTB = HALF * BK * 2  , STAGE_BYTES = 8 * HTB, NXCD = 8, WGM = 8;

__host__ __device__ __forceinline__ int lds_byte(int r, int c) { const int st = (r >> 4) * 2 + (c >> 5), rr = r & 15, cc = c & 31, ob = rr * 64 + cc * 2; return st * 1024 + (ob ^ (((ob >> 9) & 1) << 5)); }
__host__ __device__ __forceinline__ void stage_rc(int b, int& R, int& C) { const int st = b / 1024, sb = b % 1024, swz = sb ^ (((sb >> 9) & 1) << 5); R = (st >> 1) * 16 + swz / 64; C = (st & 1) * 32 + (swz % 64) / 2; }
__host__ __device__ __forceinline__ int perm32(int rho) { const int n = rho >> 4, i = rho & 15; return 8 * (i >> 2) + 4 * n + (i & 3); }

struct Unit { int pm, pn; };
struct Gemm { const bf16_t* A; const bf16_t* Bt; int M, N, K; int ppg; size_t a_gstride; };

struct StaticOrder {
    int nM, nN, nwg, G, c;
    __host__ __device__ void init(int M, int N, int G_, int c_) { nM = M / BM; nN = N / BM; nwg = nM * nN; G = G_; c = c_; }
    __host__ __device__ bool next(int i, Unit& u) const {
        const long L = (long)i * G + c; if (L >= nwg) return false;
        int wgid = (int)L; { const int q = nwg / NXCD, r = nwg % NXCD, xcd = wgid % NXCD, off = wgid / NXCD; wgid = (xcd < r ? xcd * (q + 1) : r * (q + 1) + (xcd - r) * q) + off; }
        const int nig = WGM * nN, gid = wgid / nig, fm = gid * WGM, gsz = (nM - fm) < WGM ? (nM - fm) : WGM;
        u.pm = fm + ((wgid % nig) % gsz); u.pn = (wgid % nig) / gsz; return true;
    }
    __device__ __forceinline__ void a_ready(const Unit&) const {}
    __device__ __forceinline__ void done(const Unit&) const {}
};


__device__ __forceinline__ unsigned cvt_pk_bf16(float lo, float hi) { unsigned r; asm volatile("v_cvt_pk_bf16_f32 %0, %1, %2" : "=v"(r) : "v"(lo), "v"(hi)); return r; }
typedef unsigned u32x2 __attribute__((ext_vector_type(2)));
__device__ __forceinline__ float bf_lo(unsigned w) { return __uint_as_float(w << 16); }
__device__ __forceinline__ float bf_hi(unsigned w) { return __uint_as_float(w & 0xffff0000u); }
__device__ __forceinline__ float row_rinv(const float* ss, int row) { return rsqrtf(ss[row] * (1.0f / 2048.0f) + 1e-5f); }

struct EpiResid {
    static constexpr bool PERM = false, AFTER_DRAIN = false;
    const float* base_p; const float* base_s; float* out; bf16_t* outb; float* ss;
    __device__ __forceinline__ void operator()(const f32x4 (&acc)[2][2][4][2], const Unit& u, int wr, int wc, int fr, int fq) const {
        const int col0 = u.pn * BM + wc * 32 + 4 * fq;
#pragma unroll
        for (int ai = 0; ai < 2; ++ai)
#pragma unroll
            for (int m = 0; m < 4; ++m) {
                const int row = u.pm * BM + ai * HALF + wr * 64 + m * 16 + fr;
                const float* bp = (row < 32768) ? base_p + (size_t)row * 2048 : base_s + (size_t)(row - 32768) * 2048;
                float* op = out + (size_t)row * 2048;
                float s = 0.f;
#pragma unroll
                for (int bj = 0; bj < 2; ++bj)
#pragma unroll
                    for (int n = 0; n < 2; ++n) {
                        const int col = col0 + bj * HALF + n * 16;
                        const f32x4 b = *(const f32x4*)(bp + col);
                        const f32x4 v = acc[ai][bj][m][n] + b;
                        *(f32x4*)(op + col) = v;
                        s += (v[0] * v[0] + v[1] * v[1]) + (v[2] * v[2] + v[3] * v[3]);
                        if (outb) { u32x2 w; w.x = cvt_pk_bf16(v[0], v[1]); w.y = cvt_pk_bf16(v[2], v[3]); *(u32x2*)(outb + (size_t)row * 2048 + col) = w; }
                    }
                s += __shfl_xor(s, 16); s += __shfl_xor(s, 32);
                if (fq == 0) __hip_atomic_fetch_add(ss + row, s, __ATOMIC_RELAXED, __HIP_MEMORY_SCOPE_AGENT);
                if (m & 1) asm volatile("" ::: "memory");
            }
    }
};

struct EpiGate {
    static constexpr bool PERM = true, AFTER_DRAIN = false;
    const float* ss; bf16_t* G; float* st_p; float* st_s;
    __device__ __forceinline__ void operator()(const f32x4 (&acc)[2][2][4][2], const Unit& u, int wr, int wc, int fr, int fq) const {
        const int col0 = u.pn * BM + wc * 32 + 8 * fq;
#pragma unroll
        for (int ai = 0; ai < 2; ++ai)
#pragma unroll
            for (int m = 0; m < 4; ++m) {
                const int row = u.pm * BM + ai * HALF + wr * 64 + m * 16 + fr;
                const float ri = row_rinv(ss, row);
                float* st = nullptr;
                if (row < 32768) { const int t = row & 16383; if (t >= 16382) st = st_p + (size_t)((row >> 14) * 2 + (t - 16382)) * 5632; }
                else { const int rr = row - 32768, tt = rr & 15; if (tt >= 14) st = st_s + (size_t)((rr >> 4) * 2 + (tt - 14)) * 5632; }
#pragma unroll
                for (int bj = 0; bj < 2; ++bj) {
                    const f32x4 v0 = acc[ai][bj][m][0] * ri, v1 = acc[ai][bj][m][1] * ri;
                    u32x4 w; w.x = cvt_pk_bf16(v0[0], v0[1]); w.y = cvt_pk_bf16(v0[2], v0[3]); w.z = cvt_pk_bf16(v1[0], v1[1]); w.w = cvt_pk_bf16(v1[2], v1[3]);
                    *(u32x4*)(G + (size_t)row * 5632 + col0 + bj * HALF) = w;
                    if (st) { *(f32x4*)(st + col0 + bj * HALF) = v0; *(f32x4*)(st + col0 + bj * HALF + 4) = v1; }
                }
            }
    }
};

struct EpiUp {
    static constexpr bool PERM = true, AFTER_DRAIN = false;
    const float* ss; const bf16_t* G; bf16_t* H; const float* cw; const float* cb; const float* hist;
    __device__ __forceinline__ void operator()(const f32x4 (&acc)[2][2][4][2], const Unit& u, int wr, int wc, int fr, int fq) const {
        const int col0 = u.pn * BM + wc * 32 + 8 * fq;
#pragma unroll
        for (int bj = 0; bj < 2; ++bj) {
            const int col = col0 + bj * HALF;
            float w0[8], w1[8], w2[8], bb[8];
#pragma unroll
            for (int h = 0; h < 2; ++h) {
                const f32x4 a0 = *(const f32x4*)(cw + col + 4 * h), a1 = *(const f32x4*)(cw + 5632 + col + 4 * h), a2 = *(const f32x4*)(cw + 2 * 5632 + col + 4 * h), a3 = *(const f32x4*)(cb + col + 4 * h);
#pragma unroll
                for (int i = 0; i < 4; ++i) { w0[4 * h + i] = a0[i]; w1[4 * h + i] = a1[i]; w2[4 * h + i] = a2[i]; bb[4 * h + i] = a3[i]; }
            }
#pragma unroll
            for (int ai = 0; ai < 2; ++ai)
#pragma unroll
                for (int m = 0; m < 4; ++m) {
                    const int row = u.pm * BM + ai * HALF + wr * 64 + m * 16 + fr;
                    const float ri = row_rinv(ss, row);
                    const bf16_t* gp = G + (size_t)row * 5632 + col;
                    const u32x4 gc = *(const u32x4*)gp;
                    float p1[8], p2[8];
                    int t; bool samp = row >= 32768; int rr = row - 32768;
                    t = samp ? (rr & 15) : (row & 16383);
                    if (t >= 1) { const u32x4 q = *(const u32x4*)(gp - 5632);
#pragma unroll
                        for (int i = 0; i < 4; ++i) { p1[2 * i] = bf_lo(q[i]); p1[2 * i + 1] = bf_hi(q[i]); } }
                    else if (samp) { const float* hp = hist + (size_t)((rr >> 4) * 2 + 1) * 5632 + col; const f32x4 q0 = *(const f32x4*)hp, q1 = *(const f32x4*)(hp + 4);
#pragma unroll
                        for (int i = 0; i < 4; ++i) { p1[i] = q0[i]; p1[4 + i] = q1[i]; } }
                    else {
#pragma unroll
                        for (int i = 0; i < 8; ++i) p1[i] = 0.f; }
                    if (t >= 2) { const u32x4 q = *(const u32x4*)(gp - 2 * 5632);
#pragma unroll
                        for (int i = 0; i < 4; ++i) { p2[2 * i] = bf_lo(q[i]); p2[2 * i + 1] = bf_hi(q[i]); } }
                    else if (samp) { const float* hp = hist + (size_t)((rr >> 4) * 2 + t) * 5632 + col; const f32x4 q0 = *(const f32x4*)hp, q1 = *(const f32x4*)(hp + 4);
#pragma unroll
                        for (int i = 0; i < 4; ++i) { p2[i] = q0[i]; p2[4 + i] = q1[i]; } }
                    else {
#pragma unroll
                        for (int i = 0; i < 8; ++i) p2[i] = 0.f; }
                    float o[8];
#pragma unroll
                    for (int i = 0; i < 8; ++i) {
                        const float g0 = (i & 1) ? bf_hi(gc[i >> 1]) : bf_lo(gc[i >> 1]);
                        const float cv = bb[i] + w0[i] * p2[i] + w1[i] * p1[i] + w2[i] * g0;
                        const float uu = acc[ai][bj][m][i >> 2][i & 3] * ri;
                        const float e = __builtin_amdgcn_exp2f(cv * -1.4426950408889634f);
                        o[i] = cv * __builtin_amdgcn_rcpf(1.0f + e) * uu;
                    }
                    u32x4 w; w.x = cvt_pk_bf16(o[0], o[1]); w.y = cvt_pk_bf16(o[2], o[3]); w.z = cvt_pk_bf16(o[4], o[5]); w.w = cvt_pk_bf16(o[6], o[7]);
                    *(u32x4*)(H + (size_t)row * 5632 + col) = w;
                    if (m & 1) asm volatile("" ::: "memory");
                }
        }
    }
};

struct EpiQKV {
    static constexpr bool PERM = false, AFTER_DRAIN = false;
    const float* ss; const float* cs;
    float* kout_p; float* kout_s;
    bf16_t* KB; bf16_t* KS;
    static constexpr size_t FSTR_P = 67108864, FSTR_S = 524288, BSTR_P = (size_t)129 * 1048576 / 2, BSTR_S = (size_t)264 * 1048576 / 2;
    __device__ __forceinline__ void operator()(const f32x4 (&acc)[2][2][4][2], const Unit& u, int wr, int wc, int fr, int fq) const {
        const int kind = u.pn >> 3, pnl = u.pn & 7;
#pragma unroll
        for (int ai = 0; ai < 2; ++ai)
#pragma unroll
            for (int m = 0; m < 4; ++m) {
                const int row = u.pm * BM + ai * HALF + wr * 64 + m * 16 + fr;
                const float ri = row_rinv(ss, row);
                int pos; float* fdst; bf16_t* bdst;
                if (row < 32768) { pos = row & 16383; fdst = kout_p + (size_t)(kind & 1) * FSTR_P + (size_t)row * 2048; bdst = KB + (size_t)kind * BSTR_P + (size_t)row * 2048; }
                else { const int rr = row - 32768, b = rr >> 4, tt = rr & 15; pos = 4096 + tt; fdst = kout_s + (size_t)(kind & 1) * FSTR_S + (size_t)rr * 2048;
                       if (kind == 2) bdst = KB + 2 * BSTR_P + (size_t)row * 2048; else bdst = KS + (size_t)kind * BSTR_S + (size_t)(b * 4224 + 4096 + tt) * 2048; }
                if (kind == 1) {
#pragma unroll
                    for (int bj = 0; bj < 2; ++bj)
#pragma unroll
                        for (int n = 0; n < 2; ++n) { const int col = pnl * BM + bj * HALF + wc * 32 + n * 16 + 4 * fq; const f32x4 v = acc[ai][bj][m][n] * ri;
                            *(f32x4*)(fdst + col) = v; u32x2 w; w.x = cvt_pk_bf16(v[0], v[1]); w.y = cvt_pk_bf16(v[2], v[3]); *(u32x2*)(bdst + col) = w; }
                } else {
#pragma unroll
                    for (int n = 0; n < 2; ++n) {
                        const int rho = wc * 32 + n * 16 + 4 * fq, half = rho >> 6, i0 = rho & 63;
                        const float* cp = cs + ((size_t)pos * 64 + i0) * 2;
                        const f32x4 c01 = *(const f32x4*)cp, c23 = *(const f32x4*)(cp + 4);
                        const f32x4 x1 = acc[ai][0][m][n] * ri, x2 = acc[ai][1][m][n] * ri;
                        const f32x4 co = {c01[0], c01[2], c23[0], c23[2]}, si = {c01[1], c01[3], c23[1], c23[3]};
                        const f32x4 o1 = x1 * co - x2 * si, o2 = x2 * co + x1 * si;
                        const int cbase = pnl * BM + half * HALF + i0;
                        if (kind == 0) { *(f32x4*)(fdst + cbase) = o1; *(f32x4*)(fdst + cbase + 64) = o2; }
                        u32x2 w1, w2; w1.x = cvt_pk_bf16(o1[0], o1[1]); w1.y = cvt_pk_bf16(o1[2], o1[3]); w2.x = cvt_pk_bf16(o2[0], o2[1]); w2.y = cvt_pk_bf16(o2[2], o2[3]);
                        *(u32x2*)(bdst + cbase) = w1; *(u32x2*)(bdst + cbase + 64) = w2;
                    }
                }
                if (m & 1) asm volatile("" ::: "memory");
            }
    }
};

template <class Epi, class Sched, bool ALIGN_EPI = false, bool SP2 = false>
__device__ __forceinline__ void gemm_phase(PG8_LAS unsigned char* lds, const Gemm g, const Sched& S, const Epi& E) {
    const int tid = threadIdx.x, wid = __builtin_amdgcn_readfirstlane(tid >> 6), lane = tid & 63, wr = wid >> 2, wc = wid & 3, fr = lane & 15, fq = lane >> 4;
    const int K = g.K, nt = K / BK;
    unsigned voffA[2], voffB[2];
#pragma unroll
    for (int i = 0; i < 2; ++i) { int R, C; stage_rc(tid * 16 + i * 8192, R, C); const int Rb = Epi::PERM ? ((R & ~31) + perm32(R & 31)) : R;
        voffA[i] = (unsigned)(R * K + C) * 2u; voffB[i] = (unsigned)(Rb * K + C) * 2u; }
    const size_t kstep = (size_t)(BK * 2);
    const size_t hstep = (size_t)HALF * K * 2;
    const size_t tstep = 2 * hstep;
    const unsigned ldsw = (unsigned)wid * 1024u;
    const int aoff = lds_byte(wr * 64 + fr, fq * 8), boff = lds_byte(wc * 32 + fr, fq * 8);
#define PG8_SA(b, h) (((b) * 2 + (h)) * HTB)
#define PG8_SB(b, h) ((4 + (b) * 2 + (h)) * HTB)
#define PG8_STAGE(bufoff, gbase, voff) do { _Pragma("unroll") for (int _i = 0; _i < 2; ++_i) \
        __builtin_amdgcn_global_load_lds((const unsigned*)((const char*)(gbase) + (voff)[_i]), (PG8_LAS unsigned*)(lds + (bufoff) + ldsw + _i * 8192), 16, 0, 0); } while (0)
#define PG8_LDA(dst, b, h) do { _Pragma("unroll") for (int m = 0; m < 4; ++m) _Pragma("unroll") for (int k = 0; k < 2; ++k) dst[m][k] = *(const PG8_LAS bf16x8*)(lds + PG8_SA(b, h) + aoff + m * 2048 + k * 1024); } while (0)
#define PG8_LDB(dst, b, h) do { _Pragma("unroll") for (int n = 0; n < 2; ++n) _Pragma("unroll") for (int k = 0; k < 2; ++k) dst[n][k] = *(const PG8_LAS bf16x8*)(lds + PG8_SB(b, h) + boff + n * 2048 + k * 1024); } while (0)
#define PG8_MMA(ai, bj, At, Bt) do { __builtin_amdgcn_s_setprio(1); _Pragma("unroll") for (int m = 0; m < 4; ++m) _Pragma("unroll") for (int n = 0; n < 2; ++n) _Pragma("unroll") for (int k = 0; k < 2; ++k) \
        acc[ai][bj][m][n] = __builtin_amdgcn_mfma_f32_16x16x32_bf16(Bt[n][k], At[m][k], acc[ai][bj][m][n], 0, 0, 0); __builtin_amdgcn_s_setprio(0); } while (0)
#define PG8_WAIT_V(n) asm volatile("s_waitcnt vmcnt(" #n ")" ::: "memory")
#define PG8_WAIT_L(n) asm volatile("s_waitcnt lgkmcnt(" #n ")" ::: "memory")
#define PG8_BAR __builtin_amdgcn_s_barrier()
#define PG8_SCHED __builtin_amdgcn_sched_barrier(0)
    Unit cur, nxt; int ui = 0;
    if (!S.next(0, cur)) return;
    f32x4 acc[2][2][4][2];
#pragma unroll
    for (int a = 0; a < 2; ++a)
#pragma unroll
        for (int b = 0; b < 2; ++b)
#pragma unroll
            for (int m = 0; m < 4; ++m)
#pragma unroll
                for (int n = 0; n < 2; ++n) acc[a][b][m][n] = (f32x4){0.f, 0.f, 0.f, 0.f};
    bf16x8 At[4][2], B0[2][2], B1[2][2];
    const char* cA = (const char*)g.A + (size_t)cur.pm * tstep + (size_t)(cur.pn / g.ppg) * g.a_gstride * 2; const char* cB = (const char*)g.Bt + (size_t)cur.pn * tstep;
    S.a_ready(cur);
    if constexpr (SP2) {
        PG8_STAGE(PG8_SB(0, 0), cB, voffB); PG8_STAGE(PG8_SB(0, 1), cB + hstep, voffB); PG8_STAGE(PG8_SA(0, 0), cA, voffA); PG8_STAGE(PG8_SA(0, 1), cA + hstep, voffA);
        if (wr == 1) PG8_BAR;
        PG8_WAIT_V(2); PG8_BAR;
        PG8_STAGE(PG8_SB(1, 0), cB + kstep, voffB); PG8_STAGE(PG8_SA(1, 0), cA + kstep, voffA); PG8_STAGE(PG8_SB(1, 1), cB + hstep + kstep, voffB);
        PG8_WAIT_V(6); PG8_BAR;
    } else {
        PG8_STAGE(PG8_SB(0, 0), cB, voffB); PG8_STAGE(PG8_SA(0, 0), cA, voffA); PG8_STAGE(PG8_SB(0, 1), cB + hstep, voffB); PG8_STAGE(PG8_SA(0, 1), cA + hstep, voffA);
        if (wr == 1) PG8_BAR;
        PG8_WAIT_V(4); PG8_BAR;
        PG8_STAGE(PG8_SB(1, 0), cB + kstep, voffB); PG8_STAGE(PG8_SA(1, 0), cA + kstep, voffA); PG8_STAGE(PG8_SB(1, 1), cB + hstep + kstep, voffB);
        PG8_WAIT_V(6); PG8_BAR;
    }
    for (;;) {
        const bool has_next = S.next(ui + 1, nxt);
        const char* nA = has_next ? (const char*)g.A + (size_t)nxt.pm * tstep + (size_t)(nxt.pn / g.ppg) * g.a_gstride * 2 : cA; const char* nB = has_next ? (const char*)g.Bt + (size_t)nxt.pn * tstep : cB;
        for (int t = 0; t < nt; t += 2) {
            const bool last = (t == nt - 2);
            const char* a1 = cA + (size_t)(t + 1) * kstep;
            const char* a2 = last ? nA : cA + (size_t)(t + 2) * kstep; const char* b2 = last ? nB : cB + (size_t)(t + 2) * kstep;
            const char* a3 = a2 + kstep; const char* b3 = b2 + kstep;
            if (last && has_next) S.a_ready(nxt);
            if constexpr (SP2) {
            PG8_LDB(B0, 0, 0); PG8_LDB(B1, 0, 1); PG8_SCHED; PG8_LDA(At, 0, 0); PG8_STAGE(PG8_SA(1, 1), a1 + hstep, voffA);
            PG8_WAIT_V(8); PG8_WAIT_L(0); PG8_BAR; PG8_MMA(0, 0, At, B0); PG8_MMA(0, 1, At, B1); PG8_BAR; PG8_SCHED;
            PG8_LDA(At, 0, 1); PG8_STAGE(PG8_SB(0, 0), b2, voffB); PG8_STAGE(PG8_SB(0, 1), b2 + hstep, voffB); PG8_STAGE(PG8_SA(0, 0), a2, voffA);
            PG8_WAIT_V(8); PG8_WAIT_L(0); PG8_BAR; PG8_MMA(1, 0, At, B0); PG8_MMA(1, 1, At, B1); PG8_BAR; PG8_SCHED;
            PG8_LDB(B0, 1, 0); PG8_LDB(B1, 1, 1); PG8_SCHED; PG8_LDA(At, 1, 0); PG8_STAGE(PG8_SA(0, 1), a2 + hstep, voffA);
            PG8_WAIT_V(8); PG8_WAIT_L(0); PG8_BAR; PG8_MMA(0, 0, At, B0); PG8_MMA(0, 1, At, B1); PG8_BAR; PG8_SCHED;
            PG8_LDA(At, 1, 1); PG8_STAGE(PG8_SB(1, 0), b3, voffB); PG8_STAGE(PG8_SB(1, 1), b3 + hstep, voffB); PG8_STAGE(PG8_SA(1, 0), a3, voffA);
            PG8_WAIT_V(8); PG8_WAIT_L(0); PG8_BAR; PG8_MMA(1, 0, At, B0); PG8_MMA(1, 1, At, B1); PG8_BAR; PG8_SCHED;
            } else {
            PG8_LDB(B0, 0, 0); PG8_SCHED; PG8_LDA(At, 0, 0); PG8_STAGE(PG8_SA(1, 1), a1 + hstep, voffA);
            PG8_WAIT_L(8); PG8_BAR; PG8_WAIT_L(0); PG8_MMA(0, 0, At, B0); PG8_BAR; PG8_SCHED;
            PG8_LDB(B1, 0, 1); PG8_STAGE(PG8_SB(0, 0), b2, voffB);
            PG8_BAR; PG8_WAIT_L(0); PG8_MMA(0, 1, At, B1); PG8_BAR;
            PG8_LDA(At, 0, 1); PG8_STAGE(PG8_SA(0, 0), a2, voffA);
            PG8_BAR; PG8_WAIT_L(0); PG8_MMA(1, 0, At, B0); PG8_BAR; PG8_SCHED;
            PG8_STAGE(PG8_SB(0, 1), b2 + hstep, voffB);
            PG8_WAIT_V(6); PG8_BAR; PG8_MMA(1, 1, At, B1); PG8_BAR;
            PG8_LDB(B0, 1, 0); PG8_SCHED; PG8_LDA(At, 1, 0); PG8_STAGE(PG8_SA(0, 1), a2 + hstep, voffA);
            PG8_WAIT_L(8); PG8_BAR; PG8_WAIT_L(0); PG8_MMA(0, 0, At, B0); PG8_BAR; PG8_SCHED;
            PG8_LDB(B1, 1, 1); PG8_STAGE(PG8_SB(1, 0), b3, voffB);
            PG8_BAR; PG8_WAIT_L(0); PG8_MMA(0, 1, At, B1); PG8_BAR;
            PG8_LDA(At, 1, 1); PG8_STAGE(PG8_SA(1, 0), a3, voffA);
            PG8_BAR; PG8_WAIT_L(0); PG8_MMA(1, 0, At, B0); PG8_BAR; PG8_SCHED;
            PG8_STAGE(PG8_SB(1, 1), b3 + hstep, voffB);
            PG8_WAIT_V(6); PG8_BAR; PG8_MMA(1, 1, At, B1); PG8_BAR;
            }
        }
        if constexpr (ALIGN_EPI) { if (wr == 0) PG8_BAR; }
        if constexpr (!Epi::AFTER_DRAIN) { E(acc, cur, wr, wc, fr, fq); S.done(cur); }
        if (!has_next) break;
#pragma unroll
        for (int a = 0; a < 2; ++a)
#pragma unroll
            for (int b = 0; b < 2; ++b)
#pragma unroll
                for (int m = 0; m < 4; ++m)
#pragma unroll
                    for (int n = 0; n < 2; ++n) acc[a][b][m][n] = (f32x4){0.f, 0.f, 0.f, 0.f};
        cur = nxt; cA = nA; cB = nB; ++ui;
        if constexpr (ALIGN_EPI) { if (wr == 1) PG8_BAR; }
    }
    PG8_WAIT_V(0);
    if constexpr (!ALIGN_EPI) { if (wr == 0) PG8_BAR; }
    PG8_BAR;
    if constexpr (Epi::AFTER_DRAIN) { E.fused(acc, cur, wr, wc, fr, fq, lds, wid, lane); S.done(cur); }
#undef PG8_SA
#undef PG8_SB
#undef PG8_STAGE
#undef PG8_LDA
#undef PG8_LDB
#undef PG8_MMA
#undef PG8_WAIT_V
#undef PG8_WAIT_L
#undef PG8_BAR
#undef PG8_SCHED
}
}

namespace att {
using bf16 = __hip_bfloat16;
constexpr int DH = 128, NW = 8, QBLK = 32, KVBLK = 64, LDX = 2048;
constexpr float SCALE = 0.088388347648318440f;
constexpr float THR = 8.f;
constexpr size_t SHM_V = KVBLK * DH * 2, SHM_K = KVBLK * DH * 2, SHM_ATTN = 2 * SHM_V + 2 * SHM_K + NW * 64 * 4;
using bf16x8 = __attribute__((ext_vector_type(8))) short;
using s16x4  = __attribute__((ext_vector_type(4))) short;
using f32x16 = __attribute__((ext_vector_type(16))) float;
using u32x4  = __attribute__((ext_vector_type(4))) unsigned;
#define KSWZ(row, colB) ((row) * 256 + ((colB) ^ (((row) & 7) << 4)))
#define SBAR() __builtin_amdgcn_sched_barrier(0)
__device__ __forceinline__ int crow(int r, int hi) { return (r & 3) + 8 * (r >> 2) + 4 * hi; }
__device__ __forceinline__ unsigned cvtpk(float lo, float hi) { unsigned r; asm volatile("v_cvt_pk_bf16_f32 %0, %1, %2" : "=v"(r) : "v"(lo), "v"(hi)); return r; }
__device__ __forceinline__ void partialSM(f32x16& p0, f32x16& p1, float& m_reg, float& mn, float& alpha) {
  constexpr float C = SCALE * 1.4426950408889634f;
  float pmax = p0[0]; for (int r = 1; r < 16; ++r) pmax = fmaxf(pmax, p0[r]); for (int r = 0; r < 16; ++r) pmax = fmaxf(pmax, p1[r]);
  { auto rr = __builtin_amdgcn_permlane32_swap(__float_as_uint(pmax), __float_as_uint(pmax), false, false);
    pmax = fmaxf(__uint_as_float(rr[0]), __uint_as_float(rr[1])); }
  if (__builtin_expect(__all(pmax - m_reg <= THR / SCALE), 1)) { mn = m_reg; alpha = 1.f; }
  else { mn = fmaxf(m_reg, pmax); alpha = __builtin_amdgcn_exp2f((m_reg - mn) * C); m_reg = mn; }
  float mnC = -mn * C;
  for (int r = 0; r < 16; ++r) p0[r] = fmaf(p0[r], C, mnC); for (int r = 0; r < 16; ++r) p1[r] = fmaf(p1[r], C, mnC);
  for (int r = 0; r < 16; ++r) p0[r] = __builtin_amdgcn_exp2f(p0[r]);
}
__device__ __forceinline__ void finishSM(f32x16& p0, f32x16& p1, float alpha, float& l_reg, bf16x8& pa0, bf16x8& pa1, bf16x8& pa2, bf16x8& pa3) {
  for (int r = 0; r < 16; ++r) p1[r] = __builtin_amdgcn_exp2f(p1[r]);
  float ps = 0; for (int r = 0; r < 16; ++r) ps += p0[r]; for (int r = 0; r < 16; ++r) ps += p1[r];
  { auto rr = __builtin_amdgcn_permlane32_swap(__float_as_uint(ps), __float_as_uint(ps), false, false);
    ps = __uint_as_float(rr[0]) + __uint_as_float(rr[1]); }
  l_reg = l_reg * alpha + ps;
#define PK4(P, BASE, OUT) do { unsigned a0 = cvtpk(P[BASE + 0], P[BASE + 1]), a1 = cvtpk(P[BASE + 2], P[BASE + 3]);   \
    unsigned b0 = cvtpk(P[BASE + 4], P[BASE + 5]), b1 = cvtpk(P[BASE + 6], P[BASE + 7]);                              \
    auto r0 = __builtin_amdgcn_permlane32_swap(a0, b0, false, false); auto r1 = __builtin_amdgcn_permlane32_swap(a1, b1, false, false); \
    u32x4 w = {r0[0], r1[0], r0[1], r1[1]}; OUT = *reinterpret_cast<bf16x8*>(&w); } while (0)
  PK4(p0, 0, pa0); PK4(p0, 8, pa1); PK4(p1, 0, pa2); PK4(p1, 8, pa3);
#undef PK4
}
__device__ __forceinline__ void qkt(f32x16& p0, f32x16& p1, const bf16* Ks, const bf16x8* qr, int r32, int hi) {
  p0 = f32x16{}; p1 = f32x16{};
  for (int d0 = 0; d0 < 8; ++d0) { int cb = (d0 * 16 + hi * 8) * 2;
    bf16x8 b0 = *reinterpret_cast<const bf16x8*>((const char*)Ks + KSWZ(r32, cb));
    bf16x8 b1 = *reinterpret_cast<const bf16x8*>((const char*)Ks + KSWZ(32 + r32, cb));
    p0 = __builtin_amdgcn_mfma_f32_32x32x16_bf16(b0, qr[d0], p0, 0, 0, 0);
    p1 = __builtin_amdgcn_mfma_f32_32x32x16_bf16(b1, qr[d0], p1, 0, 0, 0); }
}
__device__ __forceinline__ void kmask(f32x16& p0, f32x16& p1, int k0, int klim, int hi) {
  if (k0 + 64 > klim) {
    if (k0 >= klim) {
#pragma unroll
      for (int r = 0; r < 16; ++r) { p0[r] = -1e30f; p1[r] = -1e30f; }
    } else {
#pragma unroll
      for (int r = 0; r < 16; ++r) { const int kk = k0 + crow(r, hi); if (kk >= klim) p0[r] = -1e30f; if (kk + 32 >= klim) p1[r] = -1e30f; }
    }
  }
}
__device__ __forceinline__ int v_st(int k, int c) { const int kk = (k & ~0xC) | ((k & 4) << 1) | ((k & 8) >> 1); return ((kk >> 3) * 4 + (c >> 5)) * 512 + ((kk & 7) * 32 + (c & 31)) * 2; }
__device__ __forceinline__ int v_rd_base(int lane) { return ((lane & 3) << 3) | (((lane >> 2) & 3) << 6) | (((lane >> 4) & 1) << 5) | (((lane >> 5) & 1) << 8); }
constexpr int v_rd_off(int d0, int ks, int half) { return d0 * 512 + ks * 4096 + half * 2048; }
template <int OFF> __device__ __forceinline__ s16x4 tr_read(int vb) {
  s16x4 r; asm volatile("ds_read_b64_tr_b16 %0, %1 offset:%2" : "=&v"(r) : "v"(vb), "i"(OFF) : "memory"); return r;
}
template <int D0> __device__ __forceinline__ void pv_one(f32x16& od, int vb, bf16x8 pa0, bf16x8 pa1, bf16x8 pa2, bf16x8 pa3) {
  const s16x4 l0 = tr_read<v_rd_off(D0, 0, 0)>(vb), h0 = tr_read<v_rd_off(D0, 0, 1)>(vb), l1 = tr_read<v_rd_off(D0, 1, 0)>(vb), h1 = tr_read<v_rd_off(D0, 1, 1)>(vb);
  const s16x4 l2 = tr_read<v_rd_off(D0, 2, 0)>(vb), h2 = tr_read<v_rd_off(D0, 2, 1)>(vb), l3 = tr_read<v_rd_off(D0, 3, 0)>(vb), h3 = tr_read<v_rd_off(D0, 3, 1)>(vb);
  asm volatile("s_waitcnt lgkmcnt(0)" ::: "memory"); SBAR();
#define PK(L, H) (bf16x8){L[0], L[1], L[2], L[3], H[0], H[1], H[2], H[3]}
  od = __builtin_amdgcn_mfma_f32_32x32x16_bf16(pa0, PK(l0, h0), od, 0, 0, 0);
  od = __builtin_amdgcn_mfma_f32_32x32x16_bf16(pa1, PK(l1, h1), od, 0, 0, 0);
  od = __builtin_amdgcn_mfma_f32_32x32x16_bf16(pa2, PK(l2, h2), od, 0, 0, 0);
  od = __builtin_amdgcn_mfma_f32_32x32x16_bf16(pa3, PK(l3, h3), od, 0, 0, 0);
#undef PK
}
__device__ __forceinline__ void pv_d0(f32x16* o, int vb, bf16x8 pa0, bf16x8 pa1, bf16x8 pa2, bf16x8 pa3) {
  pv_one<0>(o[0], vb, pa0, pa1, pa2, pa3); pv_one<1>(o[1], vb, pa0, pa1, pa2, pa3); pv_one<2>(o[2], vb, pa0, pa1, pa2, pa3); pv_one<3>(o[3], vb, pa0, pa1, pa2, pa3);
}

template <bool SAMPLE, bool COMPUTE>
__device__ __forceinline__ void attn_body_impl(const bf16* __restrict__ Qb, const bf16* __restrict__ Kh, const bf16* __restrict__ Vh, bf16* __restrict__ Ob, int seq, int klim0, char* lds) {
  const int tid = threadIdx.x, wid = __builtin_amdgcn_readfirstlane(tid >> 6), lane = tid & 63, r32 = lane & 31, hi = lane >> 5;
  const int klim = SAMPLE ? klim0 : klim0 + 64 * (wid >> 1);
  bf16* V_lds = (bf16*)lds; bf16* K_lds = (bf16*)(lds + 2 * SHM_V);
  float* ws = (float*)(lds + 2 * SHM_V + 2 * SHM_K) + wid * 64; float* li_l = ws; float* al_l = ws + 32;
  float m_reg = -1e30f, l_reg = 0; f32x16 o[4] = {}; bf16x8 qr[8];
  const int qrow = SAMPLE ? (r32 & 15) : (wid * QBLK + r32);
  const bf16* Qw = Qb + (long)qrow * LDX + hi * 8;
#pragma unroll
  for (int d0 = 0; d0 < 8; ++d0) qr[d0] = *reinterpret_cast<const bf16x8*>(Qw + d0 * 16);
  const int sr = tid >> 4, sc = (tid & 15) * 8, vst0 = v_st(sr, sc), vst1 = v_st(32 + sr, sc);
  const int vb0 = (int)(uintptr_t)V_lds + v_rd_base(lane);
  constexpr int SDEPTH = 1;
  struct { bf16x8 vs0, vs1, ks0, ks1; } sr_[SDEPTH];
#define SLOAD(i, k0) do { sr_[i].vs0 = *reinterpret_cast<const bf16x8*>(&Vh[(long)((k0) + sr) * LDX + sc]); sr_[i].vs1 = *reinterpret_cast<const bf16x8*>(&Vh[(long)((k0) + 32 + sr) * LDX + sc]); \
    sr_[i].ks0 = *reinterpret_cast<const bf16x8*>(&Kh[(long)((k0) + sr) * LDX + sc]); sr_[i].ks1 = *reinterpret_cast<const bf16x8*>(&Kh[(long)((k0) + 32 + sr) * LDX + sc]); } while (0)
#define SWRITE(b, i) do { *(bf16x8*)((char*)V_lds + (b) * SHM_V + vst0) = sr_[i].vs0;          \
    *(bf16x8*)((char*)V_lds + (b) * SHM_V + vst1) = sr_[i].vs1; int kc = sc * 2;               \
    *(bf16x8*)((char*)K_lds + (b) * SHM_K + KSWZ(sr, kc)) = sr_[i].ks0;                       \
    *(bf16x8*)((char*)K_lds + (b) * SHM_K + KSWZ(32 + sr, kc)) = sr_[i].ks1; } while (0)
#define SWAIT() do { if constexpr (SDEPTH == 2) asm volatile("s_waitcnt vmcnt(4)" ::: "memory"); else asm volatile("s_waitcnt vmcnt(0)" ::: "memory"); } while (0)
#define RESC(a) do { if (__any((a) < 1.f)) { if (hi == 0) al_l[r32] = (a); asm volatile("s_waitcnt lgkmcnt(0)" ::: "memory"); \
    for (int d = 0; d < 4; ++d) for (int r = 0; r < 16; ++r) o[d][r] *= al_l[crow(r, hi)]; } } while (0)
  f32x16 pA0, pA1, pB0, pB1; float mnA, mnB, alA = 1.f, alB = 1.f; bf16x8 pa0, pa1, pa2, pa3; const int NT = seq / KVBLK;
  constexpr int SE = 0, SO = SDEPTH - 1;
  SLOAD(SE, 0); asm volatile("s_waitcnt vmcnt(0)" ::: "memory"); SWRITE(0, SE); __syncthreads();
  if constexpr (COMPUTE) { qkt(pA0, pA1, K_lds, qr, r32, hi); kmask(pA0, pA1, 0, klim, hi); partialSM(pA0, pA1, m_reg, mnA, alA); }
  SLOAD(SO, KVBLK); if constexpr (SDEPTH == 2) { if (2 < NT) SLOAD(SE, 2 * KVBLK); }
  SWAIT(); SWRITE(1, SO); __syncthreads();
  for (int j = 1; j + 1 < NT; j += 2) {
    SBAR();
    if constexpr (COMPUTE) { qkt(pB0, pB1, (bf16*)((char*)K_lds + SHM_K), qr, r32, hi); kmask(pB0, pB1, j * KVBLK, klim, hi);
      finishSM(pA0, pA1, alA, l_reg, pa0, pa1, pa2, pa3); }
    SBAR();
    SLOAD(SO, (j + SDEPTH) * KVBLK); SBAR();
    if constexpr (COMPUTE) { pv_d0(o, vb0, pa0, pa1, pa2, pa3); partialSM(pB0, pB1, m_reg, mnB, alB); }
    __syncthreads(); SWAIT(); SWRITE(0, SE);
    if constexpr (COMPUTE) { RESC(alB); } __syncthreads();
    SBAR();
    if constexpr (COMPUTE) { qkt(pA0, pA1, K_lds, qr, r32, hi); kmask(pA0, pA1, (j + 1) * KVBLK, klim, hi);
      finishSM(pB0, pB1, alB, l_reg, pa0, pa1, pa2, pa3); }
    SBAR();
    if (SDEPTH == 1 || j + 3 < NT) SLOAD(SE, (j + 1 + SDEPTH) * KVBLK); SBAR();
    if constexpr (COMPUTE) { pv_d0(o, vb0 + (int)SHM_V, pa0, pa1, pa2, pa3); partialSM(pA0, pA1, m_reg, mnA, alA); }
    __syncthreads(); SWAIT(); SWRITE(1, SO);
    if constexpr (COMPUTE) { RESC(alA); } __syncthreads();
  }
  SBAR();
  if constexpr (COMPUTE) { qkt(pB0, pB1, (bf16*)((char*)K_lds + SHM_K), qr, r32, hi); kmask(pB0, pB1, (NT - 1) * KVBLK, klim, hi);
    finishSM(pA0, pA1, alA, l_reg, pa0, pa1, pa2, pa3); }
  SBAR();
  if constexpr (COMPUTE) { pv_d0(o, vb0, pa0, pa1, pa2, pa3); partialSM(pB0, pB1, m_reg, mnB, alB); }
  __syncthreads();
  if constexpr (COMPUTE) { RESC(alB);
    finishSM(pB0, pB1, alB, l_reg, pa0, pa1, pa2, pa3); SBAR();
    pv_d0(o, vb0 + (int)SHM_V, pa0, pa1, pa2, pa3);
    if (hi == 0) li_l[r32] = l_reg; asm volatile("s_waitcnt lgkmcnt(0)" ::: "memory");
    float rli[16];
#pragma unroll
    for (int r = 0; r < 16; ++r) rli[r] = __builtin_amdgcn_rcpf(li_l[crow(r, hi)]);
    bf16* Ow = Ob + (long)(SAMPLE ? 0 : wid * QBLK) * LDX;
#pragma unroll
    for (int r = 0; r < 16; ++r) { const int orow = crow(r, hi);
      if (!SAMPLE || (orow < 16 && wid == 0)) {
#pragma unroll
        for (int d0 = 0; d0 < 4; ++d0) Ow[(long)orow * LDX + d0 * 32 + r32] = __float2bfloat16(o[d0][r] * rli[r]); } }
  }
  __syncthreads();
#undef SLOAD
#undef SWRITE
#undef SWAIT
#undef RESC
}
template <bool SAMPLE>
__device__ __forceinline__ void attn_body(const bf16* __restrict__ Qb, const bf16* __restrict__ Kh, const bf16* __restrict__ Vh, bf16* __restrict__ Ob, int seq, int klim0, char* lds) {
  attn_body_impl<SAMPLE, true>(Qb, Kh, Vh, Ob, seq, klim0, lds);
}
#undef KSWZ
#undef SBAR
}


#define GAS __attribute__((address_space(1)))
#define LAS __attribute__((address_space(3)))
typedef unsigned short bf16;
typedef unsigned v4u __attribute__((ext_vector_type(4)));
typedef float f32x4 __attribute__((ext_vector_type(4)));
typedef short bf16x8 __attribute__((ext_vector_type(8)));
typedef GAS unsigned gu32;
typedef GAS unsigned long long gu64;
#define RLX_AGENT __ATOMIC_RELAXED, __HIP_MEMORY_SCOPE_AGENT
#define LDS_WAIT() asm volatile("s_waitcnt lgkmcnt(0)" ::: "memory")
#define VM_WAIT() asm volatile("s_waitcnt vmcnt(0)" ::: "memory")
__device__ __forceinline__ unsigned long long rt() { return __builtin_amdgcn_s_memrealtime(); }
__device__ __forceinline__ unsigned f2bf(float f) { unsigned u = __builtin_bit_cast(unsigned, f); return (u + 0x7fffu + ((u >> 16) & 1u)) >> 16; }
__device__ __forceinline__ unsigned pk2(float lo, float hi) { return f2bf(lo) | (f2bf(hi) << 16); }

#define XB_TMO      128
#define XB_XCNT(j)  (256  + 64 * (j))
#define XB_XSUB(j)  (1280 + 64 * (j))
#define XB_XGEN(j)  (2304 + 64 * (j))
#define XB_TOP      3328
#define XB_TOPGEN   3392
#define XCD_BAR_WORDS 3456
#define XB_SPIN_CAP (1u << 18)

__device__ __forceinline__ unsigned xb_ld(unsigned* p)              { return __hip_atomic_load(p, __ATOMIC_RELAXED, __HIP_MEMORY_SCOPE_AGENT); }
__device__ __forceinline__ unsigned xb_add(unsigned* p, unsigned v) { return __hip_atomic_fetch_add(p, v, __ATOMIC_RELAXED, __HIP_MEMORY_SCOPE_AGENT); }
__device__ __forceinline__ unsigned xb_xcc_id() { return (unsigned)__builtin_amdgcn_s_getreg((3 << 11) | 20) & 0xFu; }
#define XB_SPIN(cond, bar) do { unsigned _sp = 0; while (cond) { __builtin_amdgcn_s_sleep(1); \
    if ((++_sp & 255u) == 0u) { if (xb_ld(&(bar)[XB_TMO])) break; if (_sp > XB_SPIN_CAP) { atomicAdd(&(bar)[XB_TMO], 1u); break; } } } } while (0)

struct XcdBarrier {
    unsigned* bar; unsigned x;
    volatile LAS unsigned* st;
};

__device__ __forceinline__ XcdBarrier xcd_barrier_post(unsigned* bar, volatile LAS unsigned* st) {
    XcdBarrier b; b.bar = bar; b.x = xb_xcc_id(); b.st = st;
    if (threadIdx.x == 0) (void)xb_add(&bar[XB_XCNT(b.x)], 1u);
    return b;
}
__device__ __forceinline__ void xcd_barrier_complete(unsigned* bar, unsigned x, unsigned& nloc, unsigned& nx) {
    const unsigned G = gridDim.x * gridDim.y * gridDim.z;
    unsigned sum, cnt, mine, sp = 0u;
    for (;;) {
        sum = 0u; cnt = 0u; mine = 0u;
#pragma unroll
        for (unsigned j = 0; j < 16; ++j) { const unsigned c = xb_ld(&bar[XB_XCNT(j)]); sum += c; cnt += (c > 0u) ? 1u : 0u; mine = (j == x) ? c : mine; }
        if (sum == G) break;
        __builtin_amdgcn_s_sleep(1);
        if ((++sp & 255u) == 0u) { if (xb_ld(&bar[XB_TMO])) break; if (sp > XB_SPIN_CAP) { atomicAdd(&bar[XB_TMO], 1u); break; } }
    }
    nloc = mine > 0u ? mine : 1u; nx = cnt > 0u ? cnt : 1u;
}

__device__ __forceinline__ void xcd_barrier(const XcdBarrier& b) {
    asm volatile("s_waitcnt vmcnt(0)" ::: "memory");
    __syncthreads();
    if (threadIdx.x == 0) {
        unsigned* bar = b.bar;
        __builtin_amdgcn_s_waitcnt(0);
        unsigned nloc = b.st[0], nx = b.st[1];
        if (nloc == 0u) { xcd_barrier_complete(bar, b.x, nloc, nx); b.st[0] = nloc; b.st[1] = nx; }
        const unsigned old = xb_add(&bar[XB_XSUB(b.x)], 1u);
        const unsigned gen = old / nloc;
        if (old + 1u == (gen + 1u) * nloc) {
            __builtin_amdgcn_fence(__ATOMIC_RELEASE, "agent");
            asm volatile("s_waitcnt vmcnt(0)" ::: "memory");
            const unsigned og = xb_add(&bar[XB_TOP], 1u);
            const unsigned tg = og / nx;
            if (og + 1u == (tg + 1u) * nx) xb_add(&bar[XB_TOPGEN], 1u);
            else XB_SPIN(xb_ld(&bar[XB_TOPGEN]) == tg, bar);
            __builtin_amdgcn_fence(__ATOMIC_ACQUIRE, "agent");
            xb_add(&bar[XB_XGEN(b.x)], 1u);
            asm volatile("s_waitcnt vmcnt(0)" ::: "memory");
        } else {
            XB_SPIN(xb_ld(&bar[XB_XGEN(b.x)]) == gen, bar);
            __builtin_amdgcn_fence(__ATOMIC_ACQUIRE, "agent");
            asm volatile("s_waitcnt vmcnt(0)" ::: "memory");
        }
    }
    __syncthreads();
}

__device__ __forceinline__ float wave_sum(float v) {
#pragma unroll
    for (int o = 1; o < 64; o <<= 1) v += __shfl_xor(v, o);
    return v;
}
__device__ __forceinline__ void tr_item(const float* W, int K, int N, bf16* WT, int row_off, int mode, const float* gk, int gmod, float gmul, const float* sn,
                                        LAS float* scr, int item, int lane) {
    const int nblk = N / 32, kb = item / nblk, nb = item % nblk, k0 = 64 * kb, n0 = 32 * nb;
    const float sv = sn ? sn[n0 + (lane & 31)] : 1.0f;
#pragma unroll 8
    for (int i = 0; i < 32; ++i) { const int kk = 2 * i + (lane >> 5); const float g = gk ? gk[(k0 + kk) % gmod] * gmul : 1.0f;
        scr[kk * 33 + (lane & 31)] = W[(size_t)(k0 + kk) * N + n0 + (lane & 31)] * g * sv; }
    LDS_WAIT(); asm volatile("" ::: "memory");
    const int c = lane & 7;
#pragma unroll
    for (int j = 0; j < 4; ++j) { const int n = (lane >> 3) + 8 * j; const LAS float* s = scr + (8 * c) * 33 + n;
        v4u o; o.x = pk2(s[0 * 33], s[1 * 33]); o.y = pk2(s[2 * 33], s[3 * 33]); o.z = pk2(s[4 * 33], s[5 * 33]); o.w = pk2(s[6 * 33], s[7 * 33]);
        const int ng = n0 + n; int rw;
        if (mode == 0) rw = ng; else { const int jj = ng & 255; rw = (ng & ~255) + 128 * ((jj & 127) >> 6) + 64 * (jj >> 7) + (jj & 63); }
        *(GAS v4u*)(WT + (size_t)(row_off + rw) * K + k0 + 8 * c) = o; }
    LDS_WAIT(); asm volatile("" ::: "memory");
}

struct Args { const float* in[26]; float* out; unsigned char* ws; int ph_lo, ph_hi; };
static_assert(sizeof(Args) == 26 * 8 + 8 + 8 + 8, "Args has no padding");

__global__ void __launch_bounds__(NWAVES * 64, 2) yoco_fwd(Args args) {
    extern __shared__ __attribute__((aligned(16))) unsigned char lds[];
    LAS unsigned char* const ldsp = (LAS unsigned char*)lds;
    volatile LAS unsigned* const MISC = (volatile LAS unsigned*)(ldsp + MISC_OFF);
    const int wave = __builtin_amdgcn_readfirstlane(threadIdx.x >> 6);
#define tid ((int)threadIdx.x)
#define lane ((int)(threadIdx.x & 63))
    const int G = gridDim.x; const int bx = blockIdx.x; const int vcu = (G % 8 == 0) ? (bx % 8) * (G / 8) + bx / 8 : bx;
    gu32* const ctl = (gu32*)(args.ws + WS_CTL);
    for (int u = tid; u < (LDS_BYTES - LDSCTL_OFF) / 4; u += NWAVES * 64) ((LAS unsigned*)(ldsp + LDSCTL_OFF))[u] = 0u;
    __syncthreads();
    XcdBarrier bar; bar.bar = (unsigned*)(ctl + CW_BAR); bar.x = 0; bar.st = nullptr;
    if (!MK_PER_PHASE) bar = xcd_barrier_post((unsigned*)(ctl + CW_BAR), MISC + 8);
    const int lo = args.ph_lo, hi = args.ph_hi;
#ifndef PHASE_MASK
#define PHASE_MASK 0xFFFF
#endif
#define IN(k) (((PHASE_MASK >> (k)) & 1) && lo <= (k) && (k) < hi)
#define SEAM(k) do { if (IN(k) && IN((k) + 1)) xcd_barrier(bar); } while (0)
    const int gw = vcu * NWAVES + wave, NGW = G * NWAVES;
#define CAS __attribute__((address_space(4)))
#define ARGP() ({ const CAS Args* p_ = (const CAS Args*)__builtin_amdgcn_kernarg_segment_ptr(); asm volatile("" : "+s"(p_)); p_; })
#define DECL_IN(name, i) const float* const name = ap_->in[i]
#define DECL_WS(type, name, off) type* const name = (type*)(ap_->ws + (off))
    if (IN(0)) {
        const CAS Args* const ap_ = ARGP(); float* const out = ap_->out; unsigned char* const ws = ap_->ws; (void)out; (void)ws;
        DECL_IN(cache_k, 4);
        DECL_IN(cache_v, 5);
        DECL_IN(norm_mix, 6);
        DECL_IN(pool_w, 7);
        DECL_IN(pool_scale, 8);
        DECL_IN(norm_kv, 9);
        DECL_IN(w_k, 10);
        DECL_IN(w_v, 11);
        DECL_IN(w_q, 12);
        DECL_IN(subln, 17);
        DECL_IN(w_o, 18);
        DECL_IN(norm_ffn, 19);
        DECL_IN(w_gate, 20);
        DECL_IN(w_up, 21);
        DECL_IN(w_down, 24);
        DECL_IN(x_prompt, 0);
        DECL_IN(x_sample, 1);
        DECL_WS(float, RINV0, WS_RINV0);
        DECL_WS(float, CS, WS_CS);
        DECL_WS(bf16, WPOOL, WS_WPOOL);
        DECL_WS(bf16, WQKV, WS_WQKV);
        DECL_WS(bf16, WO, WS_WO);
        DECL_WS(bf16, KS, WS_KS);
        DECL_WS(bf16, VS, WS_VS);

        LAS float* scr = (LAS float*)(ldsp + RING_OFF + wave * 16384);
        constexpr int I_POOL = 4 * (512 / 64) * (512 / 32), I_F = (D / 64) * (FF / 32), I_P = (D / 64) * (D / 32);
        constexpr int NITEMS = I_POOL + 6 * I_F + 4 * I_P;
        for (int it = gw; it < NITEMS; it += NGW) {
            int r = it;
            if (r < I_POOL) { const int g = r / (I_POOL / 4), ri = r % (I_POOL / 4);
                tr_item(pool_w + (size_t)g * 512 * 512, 512, 512, WPOOL, g * 512, 0, nullptr, 1, 1.f, pool_scale + g * 512, scr, ri, lane); continue; }
            r -= I_POOL;
            if (r < 6 * I_F) { const int which = r / I_F, ri = r % I_F, l = which / 3, kind = which % 3;
                bf16* dst = (bf16*)(ws + WS_WG0 + (size_t)which * 22 * MiB);
                if (kind == 0) tr_item(w_gate + (size_t)l * D * FF, D, FF, dst, 0, 0, norm_ffn + l * D, D, 1.f, nullptr, scr, ri, lane);
                else if (kind == 1) tr_item(w_up + (size_t)l * D * FF, D, FF, dst, 0, 0, norm_ffn + l * D, D, 1.f, nullptr, scr, ri, lane);
                else tr_item(w_down + (size_t)l * FF * D, FF, D, dst, 0, 0, nullptr, 1, 1.f, nullptr, scr, ri, lane);
                continue; }
            r -= 6 * I_F;
            { const int which = r / I_P, ri = r % I_P;
                if (which == 0) tr_item(w_k, D, D, WQKV, 0, 1, norm_kv, D, 1.f, nullptr, scr, ri, lane);
                else if (which == 1) tr_item(w_v, D, D, WQKV, D, 0, norm_kv, D, 1.f, nullptr, scr, ri, lane);
                else if (which == 2) tr_item(w_q, D, D, WQKV, 2 * D, 1, norm_mix + D, D, 1.f, nullptr, scr, ri, lane);
                else tr_item(w_o, D, D, WO, 0, 0, subln, 256, 1.0f - LAM_INIT, nullptr, scr, ri, lane); }
        }
        for (int e = gw * 64 + lane; e < 16384 * 64; e += NGW * 64) {
            const int pos = e >> 6, i = e & 63;
            double inv = 1.0, bs = 0.8659643233600653; int k = i;
#pragma unroll
            for (int s = 0; s < 6; ++s) { if (k & 1) inv *= bs; bs *= bs; k >>= 1; }
            const double rev = (double)pos * inv * 0.15915494309189535;
            const float fr = (float)(rev - __builtin_rint(rev));
            CS[2 * (size_t)e] = __builtin_amdgcn_cosf(fr); CS[2 * (size_t)e + 1] = __builtin_amdgcn_sinf(fr);
        }
        for (int r = gw; r < R; r += NGW) {
            const float* src = (r < RP) ? x_prompt + (size_t)r * D : x_sample + (size_t)(r - RP) * D;
            float s = 0.f;
#pragma unroll
            for (int j = 0; j < 8; ++j) { const f32x4 v = *(const f32x4*)(src + 4 * lane + 256 * j); s += (v[0] * v[0] + v[1] * v[1]) + (v[2] * v[2] + v[3] * v[3]); }
            s = wave_sum(s);
            if (lane == 0) RINV0[r] = rsqrtf(s * (1.0f / D) + EPS);
        }
        {
            const size_t nchunk = (size_t)16 * SPAST * (D / 8);
            for (size_t q = (size_t)bx * 512 + tid; q < 2 * nchunk; q += (size_t)G * 512) {
                const bool isv = q >= nchunk; const size_t qq = isv ? q - nchunk : q;
                const size_t row = qq >> 8; const int cc = (int)(qq & 255); const size_t b = row >> 12, p = row & 4095;
                const float* src = (isv ? cache_v : cache_k) + row * D + cc * 8;
                const f32x4 a = *(const f32x4*)src, c = *(const f32x4*)(src + 4);
                v4u o; o.x = pk2(a[0], a[1]); o.y = pk2(a[2], a[3]); o.z = pk2(c[0], c[1]); o.w = pk2(c[2], c[3]);
                *(v4u*)((isv ? VS : KS) + (b * SKEYS + p) * D + cc * 8) = o;
            }
            const size_t nz = (size_t)16 * (SKEYS - SLIM) * (D / 8);
            for (size_t q = (size_t)bx * 512 + tid; q < 2 * nz; q += (size_t)G * 512) {
                const bool isv = q >= nz; const size_t qq = isv ? q - nz : q;
                const size_t row = qq >> 8; const int cc = (int)(qq & 255); const size_t b = row / (SKEYS - SLIM), p = SLIM + row % (SKEYS - SLIM);
                *(v4u*)((isv ? VS : KS) + (b * SKEYS + p) * D + cc * 8) = (v4u){0u, 0u, 0u, 0u};
            }
        }
    }
    SEAM(0);

    if (IN(1)) {
        const CAS Args* const ap_ = ARGP(); float* const out = ap_->out; unsigned char* const ws = ap_->ws; (void)out; (void)ws;
        DECL_IN(x_prompt, 0);
        DECL_IN(x_sample, 1);
        DECL_IN(cache_pool, 2);
        DECL_IN(norm_mix, 6);
        DECL_WS(float, RINV0, WS_RINV0);
        DECL_WS(bf16, DB, WS_DB);

        constexpr int NSTRIP = 512 + 16;
        for (int it = gw; it < NSTRIP * 8; it += NGW) {
            const int slab = it & 7, sidx = it >> 3;
            const int c = slab * 256 + lane * 4, g = slab >> 1, w = 2 << g;
            const bool samp = sidx >= 512;
            int b, t0, nrows; const float* xb; int rowbase;
            if (!samp) { b = sidx >> 8; t0 = (sidx & 255) * 64; nrows = 64; xb = x_prompt + (size_t)b * T * D; rowbase = b * T; }
            else { b = sidx - 512; t0 = 0; nrows = 16; xb = x_sample + (size_t)b * 16 * D; rowbase = RP + b * 16; }
            const f32x4 gn = *(const f32x4*)(norm_mix + c);
            const float* hp = cache_pool + (size_t)b * 15 * D + c;
#define HV(dst, t_) do { const int tq = (t_); if (tq >= 0) { const f32x4 v_ = *(const f32x4*)(xb + (size_t)tq * D + c); const float r_ = RINV0[rowbase + tq]; dst = v_ * r_ * gn; } \
                         else if (samp) dst = *(const f32x4*)(hp + (size_t)(15 + tq) * D); else dst = (f32x4){0.f, 0.f, 0.f, 0.f}; } while (0)
            f32x4 P = {0.f, 0.f, 0.f, 0.f};
            for (int j = 1; j < w; ++j) { f32x4 v; HV(v, t0 - j); P += v; }
            for (int i = 0; i < nrows; ++i) {
                const int t = t0 + i;
                f32x4 cur; HV(cur, t);
                const f32x4 S = P + cur;
                const int cnt = samp ? w : ((t + 1 < w) ? t + 1 : w);
                const f32x4 dd = S * (1.0f / (float)cnt) - cur;
                f32x4 old; HV(old, t - w + 1);
                P = S - old;
                const size_t row = (size_t)rowbase + t;
                unsigned long long pk = (unsigned long long)pk2(dd[0], dd[1]) | ((unsigned long long)pk2(dd[2], dd[3]) << 32);
                *(unsigned long long*)(DB + ((size_t)g * R + row) * 512 + (c & 511)) = pk;
                if (!samp) { if (t >= T - 15) *(f32x4*)(out + OFF_PS_P + ((size_t)b * 15 + (t - (T - 15))) * D + c) = cur; }
                else { if (t >= 1) *(f32x4*)(out + OFF_PS_S + ((size_t)b * 15 + (t - 1)) * D + c) = cur; }
            }
#undef HV
        }
    }
    SEAM(1);

    if (IN(2)) {
        const CAS Args* const ap_ = ARGP(); float* const out = ap_->out; unsigned char* const ws = ap_->ws; (void)out; (void)ws;
        DECL_IN(x_prompt, 0);
        DECL_IN(x_sample, 1);
        DECL_WS(bf16, DB, WS_DB);
        DECL_WS(bf16, WPOOL, WS_WPOOL);
        DECL_WS(float, XA, WS_XA);
        DECL_WS(bf16, XB, WS_XB);
        DECL_WS(float, SS1, WS_SS);

        pg8::Gemm g{DB, WPOOL, R, D, 512, 2, (size_t)R * 512}; pg8::StaticOrder S; S.init(R, D, G, bx);
        pg8::EpiResid E{x_prompt, x_sample, XA, XB, SS1};
        pg8::gemm_phase<pg8::EpiResid, pg8::StaticOrder, true, true>(ldsp + RING_OFF, g, S, E);
    }
    SEAM(2);
    if (IN(3)) {
        const CAS Args* const ap_ = ARGP(); float* const out = ap_->out; unsigned char* const ws = ap_->ws; (void)out; (void)ws;
        DECL_WS(bf16, XB, WS_XB);
        DECL_WS(float, SS1, WS_SS);
        DECL_WS(bf16, GB, WS_GB);

        pg8::Gemm g{XB, (const bf16*)(ws + WS_WG0), R, FF, D, 1 << 30, 0}; pg8::StaticOrder S; S.init(R, FF, G, bx);
        pg8::EpiGate E{SS1, GB, out + OFF_FS_P, out + OFF_FS_S};
        pg8::gemm_phase<pg8::EpiGate, pg8::StaticOrder, true, true>(ldsp + RING_OFF, g, S, E);
    }
    SEAM(3);
    if (IN(4)) {
        const CAS Args* const ap_ = ARGP(); float* const out = ap_->out; unsigned char* const ws = ap_->ws; (void)out; (void)ws;
        DECL_IN(conv_w, 22);
        DECL_IN(conv_b, 23);
        DECL_IN(cache_ffn, 3);
        DECL_WS(bf16, XB, WS_XB);
        DECL_WS(float, SS1, WS_SS);
        DECL_WS(bf16, GB, WS_GB);
        DECL_WS(bf16, HB, WS_HB);

        pg8::Gemm g{XB, (const bf16*)(ws + WS_WU0), R, FF, D, 1 << 30, 0}; pg8::StaticOrder S; S.init(R, FF, G, bx);
        pg8::EpiUp E{SS1, GB, HB, conv_w, conv_b, cache_ffn};
        pg8::gemm_phase<pg8::EpiUp, pg8::StaticOrder, true, true>(ldsp + RING_OFF, g, S, E);
    }
    SEAM(4);
    if (IN(5)) {
        const CAS Args* const ap_ = ARGP(); float* const out = ap_->out; unsigned char* const ws = ap_->ws; (void)out; (void)ws;
        DECL_WS(bf16, HB, WS_HB);
        DECL_WS(float, XA, WS_XA);
        DECL_WS(bf16, XB, WS_XB);
        DECL_WS(float, SS2, WS_SS + SS_BYTES);

        pg8::Gemm g{HB, (const bf16*)(ws + WS_WD0), R, D, FF, 1 << 30, 0}; pg8::StaticOrder S; S.init(R, D, G, bx);
        pg8::EpiResid E{XA, XA + (size_t)RP * D, XA, XB, SS2};
        pg8::gemm_phase<pg8::EpiResid, pg8::StaticOrder, true, true>(ldsp + RING_OFF, g, S, E);
    }
    SEAM(5);
    if (IN(6)) {
        const CAS Args* const ap_ = ARGP(); float* const out = ap_->out; unsigned char* const ws = ap_->ws; (void)out; (void)ws;
        DECL_WS(bf16, XB, WS_XB);
        DECL_WS(bf16, WQKV, WS_WQKV);
        DECL_WS(float, SS2, WS_SS + SS_BYTES);
        DECL_WS(float, CS, WS_CS);
        DECL_WS(bf16, KB, WS_KB);
        DECL_WS(bf16, KS, WS_KS);

        pg8::Gemm g{XB, WQKV, R, 3 * D, D, 1 << 30, 0}; pg8::StaticOrder S; S.init(R, 3 * D, G, bx);
        pg8::EpiQKV E{SS2, CS, out + OFF_K_P, out + OFF_K_S, KB, KS};
        static_assert(OFF_V_P - OFF_K_P == pg8::EpiQKV::FSTR_P && OFF_V_S - OFF_K_S == pg8::EpiQKV::FSTR_S && WS_VB - WS_KB == 2 * pg8::EpiQKV::BSTR_P && WS_QB - WS_KB == 4 * pg8::EpiQKV::BSTR_P && WS_VS - WS_KS == 2 * pg8::EpiQKV::BSTR_S, "strides");
        pg8::gemm_phase<pg8::EpiQKV, pg8::StaticOrder, true, true>(ldsp + RING_OFF, g, S, E);
    }
    SEAM(6);
    if (IN(7)) {
        const CAS Args* const ap_ = ARGP(); float* const out = ap_->out; unsigned char* const ws = ap_->ws; (void)out; (void)ws;
        DECL_WS(bf16, QB, WS_QB);
        DECL_WS(bf16, KB, WS_KB);
        DECL_WS(bf16, VB, WS_VB);
        DECL_WS(bf16, KS, WS_KS);
        DECL_WS(bf16, VS, WS_VS);
        DECL_WS(bf16, O0, WS_O0);
        DECL_WS(bf16, O1, WS_O1);

        for (int u = vcu; u < 512; u += G) {
            const int bh = u >> 2, c = (u >> 1) & 1, vh = u & 1, b = bh >> 3, h = bh & 7;
            const att::bf16* Qp = (const att::bf16*)QB + ((size_t)(RP + b * 16)) * D + h * 256 + c * 128;
            const att::bf16* Kp = (const att::bf16*)KS + (size_t)b * SKEYS * D + h * 256 + c * 128;
            const att::bf16* Vp = (const att::bf16*)VS + (size_t)b * SKEYS * D + h * 256 + vh * 128;
            att::bf16* Op = (att::bf16*)(c ? O1 : O0) + ((size_t)(RP + b * 16)) * D + h * 256 + vh * 128;
            int sk_ = SKEYS, sl_ = SLIM; asm volatile("" : "+s"(sk_), "+s"(sl_));
            att::attn_body<true>(Qp, Kp, Vp, Op, sk_, sl_, (char*)lds + RING_OFF);
        }
        for (int it = 0; ; ++it) {
            const int p = vcu + G * (it >> 1); if (p >= 2048) break;
            const int combo = p >> 5, j = p & 31, qb = (it & 1) ? 63 - j : j;
            const int b = combo >> 5, h = (combo >> 2) & 7, c = (combo >> 1) & 1, vh = combo & 1;
            const att::bf16* Qp = (const att::bf16*)QB + ((size_t)b * T + qb * 256) * D + h * 256 + c * 128;
            const att::bf16* Kp = (const att::bf16*)KB + (size_t)b * T * D + h * 256 + c * 128;
            const att::bf16* Vp = (const att::bf16*)VB + (size_t)b * T * D + h * 256 + vh * 128;
            att::bf16* Op = (att::bf16*)(c ? O1 : O0) + ((size_t)b * T + qb * 256) * D + h * 256 + vh * 128;
            att::attn_body<false>(Qp, Kp, Vp, Op, qb * 256 + 256, qb * 256 + 64, (char*)lds + RING_OFF);
        }
    }
    SEAM(7);
    if (IN(8)) {
        const CAS Args* const ap_ = ARGP(); float* const out = ap_->out; unsigned char* const ws = ap_->ws; (void)out; (void)ws;
        DECL_IN(lam_q1, 13);
        DECL_IN(lam_k1, 14);
        DECL_IN(lam_q2, 15);
        DECL_IN(lam_k2, 16);
        DECL_WS(bf16, O0, WS_O0);
        DECL_WS(bf16, O1, WS_O1);
        DECL_WS(bf16, AO, WS_AO);

        float d1 = lam_q1[lane] * lam_k1[lane] + lam_q1[lane + 64] * lam_k1[lane + 64];
        float d2 = lam_q2[lane] * lam_k2[lane] + lam_q2[lane + 64] * lam_k2[lane + 64];
        d1 = wave_sum(d1); d2 = wave_sum(d2);
        const float lam = expf(d1) - expf(d2) + LAM_INIT;
        for (int r = gw; r < R; r += NGW) {
            const bf16* p0 = O0 + (size_t)r * D + 4 * lane; const bf16* p1 = O1 + (size_t)r * D + 4 * lane; bf16* po = AO + (size_t)r * D + 4 * lane;
#pragma unroll
            for (int h = 0; h < 8; ++h) {
                const unsigned long long a = *(const unsigned long long*)(p0 + h * 256), bq = *(const unsigned long long*)(p1 + h * 256);
                const unsigned a0 = (unsigned)a, a1 = (unsigned)(a >> 32), b0 = (unsigned)bq, b1 = (unsigned)(bq >> 32);
                const float o0 = pg8::bf_lo(a0) - lam * pg8::bf_lo(b0), o1 = pg8::bf_hi(a0) - lam * pg8::bf_hi(b0), o2 = pg8::bf_lo(a1) - lam * pg8::bf_lo(b1), o3 = pg8::bf_hi(a1) - lam * pg8::bf_hi(b1);
                const float ssq = wave_sum((o0 * o0 + o1 * o1) + (o2 * o2 + o3 * o3));
                const float rn = rsqrtf(ssq * (1.0f / 256.0f) + EPS);
                *(unsigned long long*)(po + h * 256) = (unsigned long long)pk2(o0 * rn, o1 * rn) | ((unsigned long long)pk2(o2 * rn, o3 * rn) << 32);
            }
        }
    }
    SEAM(8);
    if (IN(9)) {
        const CAS Args* const ap_ = ARGP(); float* const out = ap_->out; unsigned char* const ws = ap_->ws; (void)out; (void)ws;
        DECL_WS(bf16, AO, WS_AO);
        DECL_WS(bf16, WO, WS_WO);
        DECL_WS(float, XA, WS_XA);
        DECL_WS(bf16, XB, WS_XB);
        DECL_WS(float, SS3, WS_SS + 2 * SS_BYTES);

        pg8::Gemm g{AO, WO, R, D, D, 1 << 30, 0}; pg8::StaticOrder S; S.init(R, D, G, bx);
        pg8::EpiResid E{XA, XA + (size_t)RP * D, XA, XB, SS3};
        pg8::gemm_phase<pg8::EpiResid, pg8::StaticOrder, true, true>(ldsp + RING_OFF, g, S, E);
    }
    SEAM(9);
    if (IN(10)) {
        const CAS Args* const ap_ = ARGP(); float* const out = ap_->out; unsigned char* const ws = ap_->ws; (void)out; (void)ws;
        DECL_WS(bf16, XB, WS_XB);
        DECL_WS(float, SS3, WS_SS + 2 * SS_BYTES);
        DECL_WS(bf16, GB, WS_GB);

        pg8::Gemm g{XB, (const bf16*)(ws + WS_WG1), R, FF, D, 1 << 30, 0}; pg8::StaticOrder S; S.init(R, FF, G, bx);
        pg8::EpiGate E{SS3, GB, out + OFF_FS_P + 2 * 2 * FF, out + OFF_FS_S + 16 * 2 * FF};
        pg8::gemm_phase<pg8::EpiGate, pg8::StaticOrder, true, true>(ldsp + RING_OFF, g, S, E);
    }
    SEAM(10);
    if (IN(11)) {
        const CAS Args* const ap_ = ARGP(); float* const out = ap_->out; unsigned char* const ws = ap_->ws; (void)out; (void)ws;
        DECL_IN(conv_w, 22);
        DECL_IN(conv_b, 23);
        DECL_IN(cache_ffn, 3);
        DECL_WS(bf16, XB, WS_XB);
        DECL_WS(float, SS3, WS_SS + 2 * SS_BYTES);
        DECL_WS(bf16, GB, WS_GB);
        DECL_WS(bf16, HB, WS_HB);

        pg8::Gemm g{XB, (const bf16*)(ws + WS_WU1), R, FF, D, 1 << 30, 0}; pg8::StaticOrder S; S.init(R, FF, G, bx);
        pg8::EpiUp E{SS3, GB, HB, conv_w + 3 * FF, conv_b + FF, cache_ffn + 16 * 2 * FF};
        pg8::gemm_phase<pg8::EpiUp, pg8::StaticOrder, true, true>(ldsp + RING_OFF, g, S, E);
    }
    SEAM(11);
    if (IN(12)) {
        const CAS Args* const ap_ = ARGP(); float* const out = ap_->out; unsigned char* const ws = ap_->ws; (void)out; (void)ws;
        DECL_WS(bf16, HB, WS_HB);
        DECL_WS(float, XA, WS_XA);
        DECL_WS(float, SS4, WS_SS + 3 * SS_BYTES);

        pg8::Gemm g{HB, (const bf16*)(ws + WS_WD1), R, D, FF, 1 << 30, 0}; pg8::StaticOrder S; S.init(R, D, G, bx);
        pg8::EpiResid E{XA, XA + (size_t)RP * D, XA, nullptr, SS4};
        pg8::gemm_phase<pg8::EpiResid, pg8::StaticOrder, true, true>(ldsp + RING_OFF, g, S, E);
    }
    SEAM(12);
    if (IN(13)) {
        const CAS Args* const ap_ = ARGP(); float* const out = ap_->out; unsigned char* const ws = ap_->ws; (void)out; (void)ws;
        DECL_IN(norm_final, 25);
        DECL_WS(float, XA, WS_XA);
        DECL_WS(float, SS4, WS_SS + 3 * SS_BYTES);

        for (int r = gw; r < R; r += NGW) {
            const float ri = rsqrtf(SS4[r] * (1.0f / D) + EPS);
            const float* src = XA + (size_t)r * D; float* dst = (r < RP) ? out + OFF_Y_P + (size_t)r * D : out + OFF_Y_S + (size_t)(r - RP) * D;
#pragma unroll
            for (int j = 0; j < 8; ++j) { const int cidx = 4 * lane + 256 * j; const f32x4 v = *(const f32x4*)(src + cidx); const f32x4 gq = *(const f32x4*)(norm_final + cidx); *(f32x4*)(dst + cidx) = v * ri * gq; }
        }
    }
#undef IN
#undef SEAM
#undef tid
#undef lane
}

extern "C" void kernel_launch(void* const* d_in, const int* in_sizes, int n_in, void* d_out, int out_size, void* d_ws, size_t ws_size, hipStream_t stream) {
    static int grid = 0;
    if (grid == 0) {
        if (n_in != 26 || in_sizes[0] != RP * D || (size_t)out_size != OUT_TOTAL || ws_size < WS_END) {
            fprintf(stderr, "kernel_launch: shape mismatch: n_in %d in0 %d out %d ws %zu (need %zu)\n", n_in, n_in > 0 ? in_sizes[0] : -1, out_size, ws_size, (size_t)WS_END); grid = -1; return; }
        int dev = 0, cus = 0, per_cu = 0;
        if (hipGetDevice(&dev) != hipSuccess || hipDeviceGetAttribute(&cus, hipDeviceAttributeMultiprocessorCount, dev) != hipSuccess) { grid = -1; return; }
        if (hipFuncSetAttribute((const void*)yoco_fwd, hipFuncAttributeMaxDynamicSharedMemorySize, LDS_BYTES) != hipSuccess) { fprintf(stderr, "kernel_launch: hipFuncSetAttribute failed\n"); grid = -1; return; }
        if (hipOccupancyMaxActiveBlocksPerMultiprocessor(&per_cu, (const void*)yoco_fwd, NWAVES * 64, LDS_BYTES) != hipSuccess || per_cu < 1)
            fprintf(stderr, "kernel_launch: occupancy query reports %d\n", per_cu);
        (void)hipGetLastError();
        grid = cus;
    }
    if (grid < 0) return;
    if (hipMemsetAsync((char*)d_ws + WS_CTL, 0, CTL_ZERO_BYTES, stream) != hipSuccess) { fprintf(stderr, "kernel_launch: memset failed\n"); return; }
    Args a{};
    for (int i = 0; i < 26; ++i) a.in[i] = (const float*)d_in[i];
    a.out = (float*)d_out; a.ws = (unsigned char*)d_ws;
#if MK_PER_PHASE
    for (int ph = 0; ph < NPHASE; ++ph) { a.ph_lo = ph; a.ph_hi = ph + 1; hipLaunchKernelGGL(yoco_fwd, dim3(grid), dim3(NWAVES * 64), LDS_BYTES, stream, a); }
#else
    a.ph_lo = 0; a.ph_hi = NPHASE; hipLaunchKernelGGL(yoco_fwd, dim3(grid), dim3(NWAVES * 64), LDS_BYTES, stream, a);
#endif
    const hipError_t le = hipPeekAtLastError();
    if (le != hipSuccess) fprintf(stderr, "kernel_launch: launch failed: %s\n", hipGetErrorName(le));
}
```

```cpp
#include <hip/hip_runtime.h>
#include <hip/hip_bf16.h>
#include <cstdio>
#include <cstdint>

#ifndef MK_PER_PHASE
#define MK_PER_PHASE 0
#endif

#ifndef PROBE_REPEAT_MASK
#define PROBE_REPEAT_MASK 0
#endif
#define NREP(k) (((PROBE_REPEAT_MASK >> (k)) & 1) ? 2 : 1)
constexpr int D = 2048, T = 16384, RP = 32768, RS = 256, R = RP + RS, FF = 5632, NH = 8;
constexpr int SKEYS = 4224, SPAST = 4096, SLIM = 4112;
constexpr float EPS = 1e-5f;
constexpr int XBS = D + 64, FFS = FF + 64, DBS = 512 + 64;
constexpr float LAM_INIT = 0.35550930759f;
constexpr size_t OFF_Y_P = 0, OFF_Y_S = 67108864, OFF_PS_P = 67633152, OFF_PS_S = 67694592, OFF_FS_P = 68186112, OFF_FS_S = 68231168,
                 OFF_K_P = 68591616, OFF_V_P = 135700480, OFF_K_S = 202809344, OFF_V_S = 203333632, OUT_TOTAL = 203857920;
constexpr size_t MiB = 1u << 20;
constexpr size_t WS_CTL = 0, CTL_ZERO_BYTES = 1 * MiB;
constexpr size_t SS_BYTES = 135168;
constexpr size_t WS_SS = 262144;
constexpr size_t WS_RINV0 = 1 * MiB, WS_CS = 2 * MiB, WS_WPOOL = 10 * MiB, WS_WQKV = 13 * MiB, WS_WO = 38 * MiB;
constexpr size_t WS_WG0 = 47 * MiB, WS_WSTEP = 23 * MiB;
constexpr size_t WS_XA = 185 * MiB, WS_XB = 443 * MiB;
constexpr size_t WS_GB = 577 * MiB, WS_HB = 936 * MiB, WS_DB = 936 * MiB;
constexpr size_t WS_KB = 577 * MiB, WS_VB = 706 * MiB, WS_QB = 835 * MiB, WS_O0 = 964 * MiB, WS_O1 = 1093 * MiB, WS_AO = 577 * MiB;
constexpr size_t WS_KS = 1295 * MiB, WS_VS = 1559 * MiB, WS_END = 1823 * MiB;
static_assert(WS_SS + 4 * SS_BYTES <= CTL_ZERO_BYTES, "ss inside memset region");
static_assert((size_t)R * D * 4 == 258 * MiB && (size_t)R * FFS * 2 <= 359 * MiB && (size_t)R * XBS * 2 <= 134 * MiB && (size_t)4 * R * DBS * 2 <= 146 * MiB && (size_t)16 * SKEYS * D * 2 == 264 * MiB &&
              (size_t)FF * XBS * 2 <= 23 * MiB && (size_t)D * FFS * 2 <= 23 * MiB && (size_t)3 * D * XBS * 2 <= 25 * MiB && (size_t)D * XBS * 2 <= 9 * MiB && (size_t)D * DBS * 2 <= 3 * MiB, "sizes");
constexpr int CW_BAR = 4096;
constexpr int NPHASE = 14;

constexpr int RING_OFF = 0, RING_BYTES = 131072;
constexpr int LDSCTL_OFF = RING_BYTES, MISC_OFF = LDSCTL_OFF + 320;
constexpr int LDS_BYTES = 147456;
constexpr int NWAVES = 8;

__device__ __forceinline__ int hw_lane() { unsigned m = ~0u; asm volatile("" : "+s"(m)); return (int)__builtin_amdgcn_mbcnt_hi(m, __builtin_amdgcn_mbcnt_lo(m, 0u)); }
namespace pg8 {
#define PG8_LAS __attribute__((address_space(3)))
typedef unsigned short bf16_t;
typedef short bf16x8 __attribute__((ext_vector_type(8)));
typedef float f32x4 __attribute__((ext_vector_type(4)));
typedef unsigned u32x4 __attribute__((ext_vector_type(4)));
constexpr int BM = 256, BK = 64, HALF = 128, HTB = HALF * BK * 2  , STAGE_BYTES = 8 * HTB, NXCD = 8, WGM = 8;

__host__ __device__ __forceinline__ int lds_byte(int r, int c) { const int st = (r >> 4) * 2 + (c >> 5), rr = r & 15, cc = c & 31, ob = rr * 64 + cc * 2; return st * 1024 + (ob ^ (((ob >> 9) & 1) << 5)); }
__host__ __device__ __forceinline__ void stage_rc(int b, int& R, int& C) { const int st = b / 1024, sb = b % 1024, swz = sb ^ (((sb >> 9) & 1) << 5); R = (st >> 1) * 16 + swz / 64; C = (st & 1) * 32 + (swz % 64) / 2; }
__host__ __device__ __forceinline__ int perm32(int rho) { const int n = rho >> 4, i = rho & 15; return 8 * (i >> 2) + 4 * n + (i & 3); }

struct Unit { int pm, pn; };
struct Gemm { const bf16_t* A; const bf16_t* Bt; int M, N, K; int lda, ldb; int ppg; size_t a_gstride; };

struct StaticOrder {
    int nM, nN, nwg, G, c;
    __host__ __device__ void init(int M, int N, int G_, int c_) { nM = M / BM; nN = N / BM; nwg = nM * nN; G = G_; c = c_; }
    __host__ __device__ bool next(int i, Unit& u) const {
        const long L = (long)i * G + c; if (L >= nwg) return false;
        int wgid = (int)L; { const int q = nwg / NXCD, r = nwg % NXCD, xcd = wgid % NXCD, off = wgid / NXCD; wgid = (xcd < r ? xcd * (q + 1) : r * (q + 1) + (xcd - r) * q) + off; }
        const int nig = WGM * nN, gid = wgid / nig, fm = gid * WGM, gsz = (nM - fm) < WGM ? (nM - fm) : WGM;
        u.pm = fm + ((wgid % nig) % gsz); u.pn = (wgid % nig) / gsz; return true;
    }
    __device__ __forceinline__ void a_ready(const Unit&) const {}
    __device__ __forceinline__ void done(const Unit&) const {}
};


__device__ __forceinline__ unsigned cvt_pk_bf16(float lo, float hi) { unsigned r; asm volatile("v_cvt_pk_bf16_f32 %0, %1, %2" : "=v"(r) : "v"(lo), "v"(hi)); return r; }
typedef unsigned u32x2 __attribute__((ext_vector_type(2)));
__device__ __forceinline__ float bf_lo(unsigned w) { return __uint_as_float(w << 16); }
__device__ __forceinline__ float bf_hi(unsigned w) { return __uint_as_float(w & 0xffff0000u); }
__device__ __forceinline__ float row_rinv(const float* ss, int row) { return rsqrtf(ss[row] * (1.0f / 2048.0f) + 1e-5f); }

struct EpiResid {
    static constexpr bool PERM = false, AFTER_DRAIN = false;
    const float* base_p; const float* base_s; float* out; bf16_t* outb; float* ss;
    __device__ __forceinline__ void operator()(const f32x4 (&acc)[2][2][4][2], const Unit& u, int wr, int wc, int fr, int fq) const {
        const int col0 = u.pn * BM + wc * 32 + 4 * fq;
#pragma unroll
        for (int ai = 0; ai < 2; ++ai)
#pragma unroll
            for (int m = 0; m < 4; ++m) {
                const int row = u.pm * BM + ai * HALF + wr * 64 + m * 16 + fr;
                const float* bp = (row < 32768) ? base_p + (size_t)row * 2048 : base_s + (size_t)(row - 32768) * 2048;
                float* op = out + (size_t)row * 2048;
                float s = 0.f;
#pragma unroll
                for (int bj = 0; bj < 2; ++bj)
#pragma unroll
                    for (int n = 0; n < 2; ++n) {
                        const int col = col0 + bj * HALF + n * 16;
                        const f32x4 b = *(const f32x4*)(bp + col);
                        const f32x4 v = acc[ai][bj][m][n] + b;
                        *(f32x4*)(op + col) = v;
                        s += (v[0] * v[0] + v[1] * v[1]) + (v[2] * v[2] + v[3] * v[3]);
                        if (outb) { u32x2 w; w.x = cvt_pk_bf16(v[0], v[1]); w.y = cvt_pk_bf16(v[2], v[3]); *(u32x2*)(outb + (size_t)row * 2112 + col) = w; }
                    }
                s += __shfl_xor(s, 16); s += __shfl_xor(s, 32);
                if (fq == 0) __hip_atomic_fetch_add(ss + row, s, __ATOMIC_RELAXED, __HIP_MEMORY_SCOPE_AGENT);
                if (m & 1) asm volatile("" ::: "memory");
            }
    }
};

struct EpiGate {
    static constexpr bool PERM = true, AFTER_DRAIN = false;
    const float* ss; bf16_t* G; float* st_p; float* st_s;
    __device__ __forceinline__ void operator()(const f32x4 (&acc)[2][2][4][2], const Unit& u, int wr, int wc, int fr, int fq) const {
        const int col0 = u.pn * BM + wc * 32 + 8 * fq;
#pragma unroll
        for (int ai = 0; ai < 2; ++ai)
#pragma unroll
            for (int m = 0; m < 4; ++m) {
                const int row = u.pm * BM + ai * HALF + wr * 64 + m * 16 + fr;
                const float ri = row_rinv(ss, row);
                float* st = nullptr;
                if (row < 32768) { const int t = row & 16383; if (t >= 16382) st = st_p + (size_t)((row >> 14) * 2 + (t - 16382)) * 5632; }
                else { const int rr = row - 32768, tt = rr & 15; if (tt >= 14) st = st_s + (size_t)((rr >> 4) * 2 + (tt - 14)) * 5632; }
#pragma unroll
                for (int bj = 0; bj < 2; ++bj) {
                    const f32x4 v0 = acc[ai][bj][m][0] * ri, v1 = acc[ai][bj][m][1] * ri;
                    u32x4 w; w.x = cvt_pk_bf16(v0[0], v0[1]); w.y = cvt_pk_bf16(v0[2], v0[3]); w.z = cvt_pk_bf16(v1[0], v1[1]); w.w = cvt_pk_bf16(v1[2], v1[3]);
                    *(u32x4*)(G + (size_t)row * 5696 + col0 + bj * HALF) = w;
                    if (st) { *(f32x4*)(st + col0 + bj * HALF) = v0; *(f32x4*)(st + col0 + bj * HALF + 4) = v1; }
                }
            }
    }
};

struct EpiUp {
    static constexpr bool PERM = true, AFTER_DRAIN = false;
    const float* ss; const bf16_t* G; bf16_t* H; const float* cw; const float* cb; const float* hist;
    __device__ __forceinline__ void operator()(const f32x4 (&acc)[2][2][4][2], const Unit& u, int wr, int wc, int fr, int fq) const {
        const int col0 = u.pn * BM + wc * 32 + 8 * fq;
#pragma unroll
        for (int bj = 0; bj < 2; ++bj) {
            const int col = col0 + bj * HALF;
            float w0[8], w1[8], w2[8], bb[8];
#pragma unroll
            for (int h = 0; h < 2; ++h) {
                const f32x4 a0 = *(const f32x4*)(cw + col + 4 * h), a1 = *(const f32x4*)(cw + 5632 + col + 4 * h), a2 = *(const f32x4*)(cw + 2 * 5632 + col + 4 * h), a3 = *(const f32x4*)(cb + col + 4 * h);
#pragma unroll
                for (int i = 0; i < 4; ++i) { w0[4 * h + i] = a0[i]; w1[4 * h + i] = a1[i]; w2[4 * h + i] = a2[i]; bb[4 * h + i] = a3[i]; }
            }
#pragma unroll
            for (int ai = 0; ai < 2; ++ai)
#pragma unroll
                for (int m = 0; m < 4; ++m) {
                    const int row = u.pm * BM + ai * HALF + wr * 64 + m * 16 + fr;
                    const float ri = row_rinv(ss, row);
                    const bf16_t* gp = G + (size_t)row * 5696 + col;
                    const u32x4 gc = *(const u32x4*)gp;
                    float p1[8], p2[8];
                    int t; bool samp = row >= 32768; int rr = row - 32768;
                    t = samp ? (rr & 15) : (row & 16383);
                    if (t >= 1) { const u32x4 q = *(const u32x4*)(gp - 5696);
#pragma unroll
                        for (int i = 0; i < 4; ++i) { p1[2 * i] = bf_lo(q[i]); p1[2 * i + 1] = bf_hi(q[i]); } }
                    else if (samp) { const float* hp = hist + (size_t)((rr >> 4) * 2 + 1) * 5632 + col; const f32x4 q0 = *(const f32x4*)hp, q1 = *(const f32x4*)(hp + 4);
#pragma unroll
                        for (int i = 0; i < 4; ++i) { p1[i] = q0[i]; p1[4 + i] = q1[i]; } }
                    else {
#pragma unroll
                        for (int i = 0; i < 8; ++i) p1[i] = 0.f; }
                    if (t >= 2) { const u32x4 q = *(const u32x4*)(gp - 2 * 5696);
#pragma unroll
                        for (int i = 0; i < 4; ++i) { p2[2 * i] = bf_lo(q[i]); p2[2 * i + 1] = bf_hi(q[i]); } }
                    else if (samp) { const float* hp = hist + (size_t)((rr >> 4) * 2 + t) * 5632 + col; const f32x4 q0 = *(const f32x4*)hp, q1 = *(const f32x4*)(hp + 4);
#pragma unroll
                        for (int i = 0; i < 4; ++i) { p2[i] = q0[i]; p2[4 + i] = q1[i]; } }
                    else {
#pragma unroll
                        for (int i = 0; i < 8; ++i) p2[i] = 0.f; }
                    float o[8];
#pragma unroll
                    for (int i = 0; i < 8; ++i) {
                        const float g0 = (i & 1) ? bf_hi(gc[i >> 1]) : bf_lo(gc[i >> 1]);
                        const float cv = bb[i] + w0[i] * p2[i] + w1[i] * p1[i] + w2[i] * g0;
                        const float uu = acc[ai][bj][m][i >> 2][i & 3] * ri;
                        const float e = __builtin_amdgcn_exp2f(cv * -1.4426950408889634f);
                        o[i] = cv * __builtin_amdgcn_rcpf(1.0f + e) * uu;
                    }
                    u32x4 w; w.x = cvt_pk_bf16(o[0], o[1]); w.y = cvt_pk_bf16(o[2], o[3]); w.z = cvt_pk_bf16(o[4], o[5]); w.w = cvt_pk_bf16(o[6], o[7]);
                    *(u32x4*)(H + (size_t)row * 5696 + col) = w;
                    if (m & 1) asm volatile("" ::: "memory");
                }
        }
    }
};

struct EpiQKV {
    static constexpr bool PERM = false, AFTER_DRAIN = false;
    const float* ss; const float* cs;
    float* kout_p; float* kout_s; float* vout_p; float* vout_s;
    bf16_t* KB; bf16_t* VB; bf16_t* QB; bf16_t* KS; bf16_t* VS;
    __device__ __forceinline__ void operator()(const f32x4 (&acc)[2][2][4][2], const Unit& u, int wr, int wc, int fr, int fq) const {
        const int kind = u.pn >> 3, pnl = u.pn & 7;
        if (kind == 1) {
#pragma unroll
            for (int ai = 0; ai < 2; ++ai)
#pragma unroll
                for (int m = 0; m < 4; ++m) {
                    const int row = u.pm * BM + ai * HALF + wr * 64 + m * 16 + fr;
                    const float ri = row_rinv(ss, row);
                    float* fdst; bf16_t* bdst;
                    if (row < 32768) { fdst = vout_p + (size_t)row * 2048 + pnl * BM; bdst = VB + ((size_t)((row >> 14) * 8 + pnl) * 16384 + (row & 16383)) * 256; }
                    else { const int rr = row - 32768; fdst = vout_s + (size_t)rr * 2048 + pnl * BM; bdst = VS + ((size_t)((rr >> 4) * 8 + pnl) * 4224 + 4096 + (rr & 15)) * 256; }
#pragma unroll
                    for (int bj = 0; bj < 2; ++bj)
#pragma unroll
                        for (int n = 0; n < 2; ++n) { const int e = bj * HALF + wc * 32 + n * 16 + 4 * fq; const f32x4 v = acc[ai][bj][m][n] * ri;
                            *(f32x4*)(fdst + e) = v; u32x2 w; w.x = cvt_pk_bf16(v[0], v[1]); w.y = cvt_pk_bf16(v[2], v[3]); *(u32x2*)(bdst + e) = w; }
                    if (m & 1) asm volatile("" ::: "memory");
                }
        } else {
            const int half = wc >> 1;
#pragma unroll
            for (int ai = 0; ai < 2; ++ai)
#pragma unroll
                for (int m = 0; m < 4; ++m) {
                    const int row = u.pm * BM + ai * HALF + wr * 64 + m * 16 + fr;
                    const float ri = row_rinv(ss, row);
                    int pos; float* fdst = nullptr; bf16_t* bdst;
                    if (kind == 0) {
                        if (row < 32768) { pos = row & 16383; fdst = kout_p + (size_t)row * 2048 + pnl * BM + half * HALF; bdst = KB + ((size_t)(((row >> 14) * 8 + pnl) * 2 + half) * 16384 + pos) * 128; }
                        else { const int rr = row - 32768; pos = 4096 + (rr & 15); fdst = kout_s + (size_t)rr * 2048 + pnl * BM + half * HALF; bdst = KS + ((size_t)(((rr >> 4) * 8 + pnl) * 2 + half) * 4224 + pos) * 128; }
                    } else {
                        pos = (row < 32768) ? (row & 16383) : 4096 + ((row - 32768) & 15);
                        bdst = QB + (size_t)row * 2048 + pnl * BM + half * HALF;
                    }
#pragma unroll
                    for (int n = 0; n < 2; ++n) {
                        const int i0 = (wc * 32 + n * 16 + 4 * fq) & 63;
                        const float* cp = cs + ((size_t)pos * 64 + i0) * 2;
                        const f32x4 c01 = *(const f32x4*)cp, c23 = *(const f32x4*)(cp + 4);
                        const f32x4 x1 = acc[ai][0][m][n] * ri, x2 = acc[ai][1][m][n] * ri;
                        const f32x4 co = {c01[0], c01[2], c23[0], c23[2]}, si = {c01[1], c01[3], c23[1], c23[3]};
                        const f32x4 o1 = x1 * co - x2 * si, o2 = x2 * co + x1 * si;
                        if (kind == 0) { *(f32x4*)(fdst + i0) = o1; *(f32x4*)(fdst + i0 + 64) = o2; }
                        u32x2 w1, w2; w1.x = cvt_pk_bf16(o1[0], o1[1]); w1.y = cvt_pk_bf16(o1[2], o1[3]); w2.x = cvt_pk_bf16(o2[0], o2[1]); w2.y = cvt_pk_bf16(o2[2], o2[3]);
                        *(u32x2*)(bdst + i0) = w1; *(u32x2*)(bdst + i0 + 64) = w2;
                    }
                    if (m & 1) asm volatile("" ::: "memory");
                }
        }
    }
};

template <class Epi, class Sched, bool ALIGN_EPI = false, bool SP2 = false>
__device__ __forceinline__ void gemm_phase(PG8_LAS unsigned char* lds, const Gemm g, const Sched& S, const Epi& E, int tid_in) {
    const int tid = tid_in, wid = __builtin_amdgcn_readfirstlane(tid >> 6), lane = tid & 63, wr = wid >> 2, wc = wid & 3, fr = lane & 15, fq = lane >> 4;
    const int K = g.K, nt = K / BK;
    unsigned voffA[2], voffB[2];
#pragma unroll
    for (int i = 0; i < 2; ++i) { int R, C; stage_rc(tid * 16 + i * 8192, R, C); const int Rb = Epi::PERM ? ((R & ~31) + perm32(R & 31)) : R;
        voffA[i] = (unsigned)(R * g.lda + C) * 2u; voffB[i] = (unsigned)(Rb * g.ldb + C) * 2u; }
    const size_t kstep = (size_t)(BK * 2);
    const size_t hstepA = (size_t)HALF * g.lda * 2, hstepB = (size_t)HALF * g.ldb * 2;
    const size_t tstepA = 2 * hstepA, tstepB = 2 * hstepB;
    const unsigned ldsw = (unsigned)wid * 1024u;
    const int aoff = lds_byte(wr * 64 + fr, fq * 8), boff = lds_byte(wc * 32 + fr, fq * 8);
#define PG8_SA(b, h) (((b) * 2 + (h)) * HTB)
#define PG8_SB(b, h) ((4 + (b) * 2 + (h)) * HTB)
#define PG8_STAGE(bufoff, gbase, voff) do { _Pragma("unroll") for (int _i = 0; _i < 2; ++_i) \
        __builtin_amdgcn_global_load_lds((const unsigned*)((const char*)(gbase) + (voff)[_i]), (PG8_LAS unsigned*)(lds + (bufoff) + ldsw + _i * 8192), 16, 0, 0); } while (0)
#define PG8_LDA(dst, b, h) do { _Pragma("unroll") for (int m = 0; m < 4; ++m) _Pragma("unroll") for (int k = 0; k < 2; ++k) dst[m][k] = *(const PG8_LAS bf16x8*)(lds + PG8_SA(b, h) + aoff + m * 2048 + k * 1024); } while (0)
#define PG8_LDB(dst, b, h) do { _Pragma("unroll") for (int n = 0; n < 2; ++n) _Pragma("unroll") for (int k = 0; k < 2; ++k) dst[n][k] = *(const PG8_LAS bf16x8*)(lds + PG8_SB(b, h) + boff + n * 2048 + k * 1024); } while (0)
#define PG8_MMA(ai, bj, At, Bt) do { __builtin_amdgcn_s_setprio(1); _Pragma("unroll") for (int m = 0; m < 4; ++m) _Pragma("unroll") for (int n = 0; n < 2; ++n) _Pragma("unroll") for (int k = 0; k < 2; ++k) \
        acc[ai][bj][m][n] = __builtin_amdgcn_mfma_f32_16x16x32_bf16(Bt[n][k], At[m][k], acc[ai][bj][m][n], 0, 0, 0); __builtin_amdgcn_s_setprio(0); } while (0)
#define PG8_WAIT_V(n) asm volatile("s_waitcnt vmcnt(" #n ")" ::: "memory")
#define PG8_WAIT_L(n) asm volatile("s_waitcnt lgkmcnt(" #n ")" ::: "memory")
#define PG8_BAR __builtin_amdgcn_s_barrier()
#define PG8_SCHED __builtin_amdgcn_sched_barrier(0)
    Unit cur, nxt; int ui = 0;
    if (!S.next(0, cur)) return;
    f32x4 acc[2][2][4][2];
#pragma unroll
    for (int a = 0; a < 2; ++a)
#pragma unroll
        for (int b = 0; b < 2; ++b)
#pragma unroll
            for (int m = 0; m < 4; ++m)
#pragma unroll
                for (int n = 0; n < 2; ++n) acc[a][b][m][n] = (f32x4){0.f, 0.f, 0.f, 0.f};
    bf16x8 At[4][2], B0[2][2], B1[2][2];
    const char* cA = (const char*)g.A + (size_t)cur.pm * tstepA + (size_t)(cur.pn / g.ppg) * g.a_gstride * 2; const char* cB = (const char*)g.Bt + (size_t)cur.pn * tstepB;
    S.a_ready(cur);
    if constexpr (SP2) {
        PG8_STAGE(PG8_SB(0, 0), cB, voffB); PG8_STAGE(PG8_SB(0, 1), cB + hstepB, voffB); PG8_STAGE(PG8_SA(0, 0), cA, voffA); PG8_STAGE(PG8_SA(0, 1), cA + hstepA, voffA);
        if (wr == 1) PG8_BAR;
        PG8_WAIT_V(2); PG8_BAR;
        PG8_STAGE(PG8_SB(1, 0), cB + kstep, voffB); PG8_STAGE(PG8_SA(1, 0), cA + kstep, voffA); PG8_STAGE(PG8_SB(1, 1), cB + hstepB + kstep, voffB);
        PG8_WAIT_V(6); PG8_BAR;
    } else {
        PG8_STAGE(PG8_SB(0, 0), cB, voffB); PG8_STAGE(PG8_SA(0, 0), cA, voffA); PG8_STAGE(PG8_SB(0, 1), cB + hstepB, voffB); PG8_STAGE(PG8_SA(0, 1), cA + hstepA, voffA);
        if (wr == 1) PG8_BAR;
        PG8_WAIT_V(4); PG8_BAR;
        PG8_STAGE(PG8_SB(1, 0), cB + kstep, voffB); PG8_STAGE(PG8_SA(1, 0), cA + kstep, voffA); PG8_STAGE(PG8_SB(1, 1), cB + hstepB + kstep, voffB);
        PG8_WAIT_V(6); PG8_BAR;
    }
    for (;;) {
        const bool has_next = S.next(ui + 1, nxt);
        const char* nA = has_next ? (const char*)g.A + (size_t)nxt.pm * tstepA + (size_t)(nxt.pn / g.ppg) * g.a_gstride * 2 : cA; const char* nB = has_next ? (const char*)g.Bt + (size_t)nxt.pn * tstepB : cB;
        for (int t = 0; t < nt; t += 2) {
            const bool last = (t == nt - 2);
            const char* a1 = cA + (size_t)(t + 1) * kstep;
            const char* a2 = last ? nA : cA + (size_t)(t + 2) * kstep; const char* b2 = last ? nB : cB + (size_t)(t + 2) * kstep;
            const char* a3 = a2 + kstep; const char* b3 = b2 + kstep;
            if (last && has_next) S.a_ready(nxt);
            if constexpr (SP2) {
            PG8_LDB(B0, 0, 0); PG8_LDB(B1, 0, 1); PG8_SCHED; PG8_LDA(At, 0, 0); PG8_STAGE(PG8_SA(1, 1), a1 + hstepA, voffA);
            PG8_WAIT_V(8); PG8_WAIT_L(0); PG8_BAR; PG8_MMA(0, 0, At, B0); PG8_MMA(0, 1, At, B1); PG8_BAR; PG8_SCHED;
            PG8_LDA(At, 0, 1); PG8_STAGE(PG8_SB(0, 0), b2, voffB); PG8_STAGE(PG8_SB(0, 1), b2 + hstepB, voffB); PG8_STAGE(PG8_SA(0, 0), a2, voffA);
            PG8_WAIT_V(8); PG8_WAIT_L(0); PG8_BAR; PG8_MMA(1, 0, At, B0); PG8_MMA(1, 1, At, B1); PG8_BAR; PG8_SCHED;
            PG8_LDB(B0, 1, 0); PG8_LDB(B1, 1, 1); PG8_SCHED; PG8_LDA(At, 1, 0); PG8_STAGE(PG8_SA(0, 1), a2 + hstepA, voffA);
            PG8_WAIT_V(8); PG8_WAIT_L(0); PG8_BAR; PG8_MMA(0, 0, At, B0); PG8_MMA(0, 1, At, B1); PG8_BAR; PG8_SCHED;
            PG8_LDA(At, 1, 1); PG8_STAGE(PG8_SB(1, 0), b3, voffB); PG8_STAGE(PG8_SB(1, 1), b3 + hstepB, voffB); PG8_STAGE(PG8_SA(1, 0), a3, voffA);
            PG8_WAIT_V(8); PG8_WAIT_L(0); PG8_BAR; PG8_MMA(1, 0, At, B0); PG8_MMA(1, 1, At, B1); PG8_BAR; PG8_SCHED;
            } else {
            PG8_LDB(B0, 0, 0); PG8_SCHED; PG8_LDA(At, 0, 0); PG8_STAGE(PG8_SA(1, 1), a1 + hstepA, voffA);
            PG8_WAIT_L(8); PG8_BAR; PG8_WAIT_L(0); PG8_MMA(0, 0, At, B0); PG8_BAR; PG8_SCHED;
            PG8_LDB(B1, 0, 1); PG8_STAGE(PG8_SB(0, 0), b2, voffB);
            PG8_BAR; PG8_WAIT_L(0); PG8_MMA(0, 1, At, B1); PG8_BAR;
            PG8_LDA(At, 0, 1); PG8_STAGE(PG8_SA(0, 0), a2, voffA);
            PG8_BAR; PG8_WAIT_L(0); PG8_MMA(1, 0, At, B0); PG8_BAR; PG8_SCHED;
            PG8_STAGE(PG8_SB(0, 1), b2 + hstepB, voffB);
            PG8_WAIT_V(6); PG8_BAR; PG8_MMA(1, 1, At, B1); PG8_BAR;
            PG8_LDB(B0, 1, 0); PG8_SCHED; PG8_LDA(At, 1, 0); PG8_STAGE(PG8_SA(0, 1), a2 + hstepA, voffA);
            PG8_WAIT_L(8); PG8_BAR; PG8_WAIT_L(0); PG8_MMA(0, 0, At, B0); PG8_BAR; PG8_SCHED;
            PG8_LDB(B1, 1, 1); PG8_STAGE(PG8_SB(1, 0), b3, voffB);
            PG8_BAR; PG8_WAIT_L(0); PG8_MMA(0, 1, At, B1); PG8_BAR;
            PG8_LDA(At, 1, 1); PG8_STAGE(PG8_SA(1, 0), a3, voffA);
            PG8_BAR; PG8_WAIT_L(0); PG8_MMA(1, 0, At, B0); PG8_BAR; PG8_SCHED;
            PG8_STAGE(PG8_SB(1, 1), b3 + hstepB, voffB);
            PG8_WAIT_V(6); PG8_BAR; PG8_MMA(1, 1, At, B1); PG8_BAR;
            }
        }
        if constexpr (ALIGN_EPI) { if (wr == 0) PG8_BAR; }
        if constexpr (!Epi::AFTER_DRAIN) { E(acc, cur, wr, wc, fr, fq); S.done(cur); }
        if (!has_next) break;
#pragma unroll
        for (int a = 0; a < 2; ++a)
#pragma unroll
            for (int b = 0; b < 2; ++b)
#pragma unroll
                for (int m = 0; m < 4; ++m)
#pragma unroll
                    for (int n = 0; n < 2; ++n) acc[a][b][m][n] = (f32x4){0.f, 0.f, 0.f, 0.f};
        cur = nxt; cA = nA; cB = nB; ++ui;
        if constexpr (ALIGN_EPI) { if (wr == 1) PG8_BAR; }
    }
    PG8_WAIT_V(0);
    if constexpr (!ALIGN_EPI) { if (wr == 0) PG8_BAR; }
    PG8_BAR;
    if constexpr (Epi::AFTER_DRAIN) { E.fused(acc, cur, wr, wc, fr, fq, lds, wid, lane); S.done(cur); }
#undef PG8_SA
#undef PG8_SB
#undef PG8_STAGE
#undef PG8_LDA
#undef PG8_LDB
#undef PG8_MMA
#undef PG8_WAIT_V
#undef PG8_WAIT_L
#undef PG8_BAR
#undef PG8_SCHED
}
}

namespace att {
using bf16 = __hip_bfloat16;
constexpr int DH = 128, NW = 8, QBLK = 32, KVBLK = 64, LDX = 2048;
constexpr float SCALE = 0.088388347648318440f;
constexpr float THR = 8.f;
constexpr size_t SHM_V = KVBLK * DH * 2, SHM_K = KVBLK * DH * 2, SHM_ATTN = 2 * SHM_V + 2 * SHM_K + NW * 64 * 4;
using bf16x8 = __attribute__((ext_vector_type(8))) short;
using s16x4  = __attribute__((ext_vector_type(4))) short;
using f32x16 = __attribute__((ext_vector_type(16))) float;
using u32x4  = __attribute__((ext_vector_type(4))) unsigned;
#define KSWZ(row, colB) ((row) * 256 + ((colB) ^ (((row) & 7) << 4)))
#define SBAR() __builtin_amdgcn_sched_barrier(0)
__device__ __forceinline__ int crow(int r, int hi) { return (r & 3) + 8 * (r >> 2) + 4 * hi; }
__device__ __forceinline__ unsigned cvtpk(float lo, float hi) { unsigned r; asm volatile("v_cvt_pk_bf16_f32 %0, %1, %2" : "=v"(r) : "v"(lo), "v"(hi)); return r; }
__device__ __forceinline__ void partialSM(f32x16& p0, f32x16& p1, float& m_reg, float& mn, float& alpha) {
  constexpr float C = SCALE * 1.4426950408889634f;
  float pmax = p0[0]; for (int r = 1; r < 16; ++r) pmax = fmaxf(pmax, p0[r]); for (int r = 0; r < 16; ++r) pmax = fmaxf(pmax, p1[r]);
  { auto rr = __builtin_amdgcn_permlane32_swap(__float_as_uint(pmax), __float_as_uint(pmax), false, false);
    pmax = fmaxf(__uint_as_float(rr[0]), __uint_as_float(rr[1])); }
  if (__builtin_expect(__all(pmax - m_reg <= THR / SCALE), 1)) { mn = m_reg; alpha = 1.f; }
  else { mn = fmaxf(m_reg, pmax); alpha = __builtin_amdgcn_exp2f((m_reg - mn) * C); m_reg = mn; }
  float mnC = -mn * C;
  for (int r = 0; r < 16; ++r) p0[r] = fmaf(p0[r], C, mnC); for (int r = 0; r < 16; ++r) p1[r] = fmaf(p1[r], C, mnC);
  for (int r = 0; r < 16; ++r) p0[r] = __builtin_amdgcn_exp2f(p0[r]);
}
__device__ __forceinline__ void finishSM(f32x16& p0, f32x16& p1, float alpha, float& l_reg, bf16x8& pa0, bf16x8& pa1, bf16x8& pa2, bf16x8& pa3) {
  for (int r = 0; r < 16; ++r) p1[r] = __builtin_amdgcn_exp2f(p1[r]);
  float ps = 0; for (int r = 0; r < 16; ++r) ps += p0[r]; for (int r = 0; r < 16; ++r) ps += p1[r];
  { auto rr = __builtin_amdgcn_permlane32_swap(__float_as_uint(ps), __float_as_uint(ps), false, false);
    ps = __uint_as_float(rr[0]) + __uint_as_float(rr[1]); }
  l_reg = l_reg * alpha + ps;
#define PK4(P, BASE, OUT) do { unsigned a0 = cvtpk(P[BASE + 0], P[BASE + 1]), a1 = cvtpk(P[BASE + 2], P[BASE + 3]);   \
    unsigned b0 = cvtpk(P[BASE + 4], P[BASE + 5]), b1 = cvtpk(P[BASE + 6], P[BASE + 7]);                              \
    auto r0 = __builtin_amdgcn_permlane32_swap(a0, b0, false, false); auto r1 = __builtin_amdgcn_permlane32_swap(a1, b1, false, false); \
    u32x4 w = {r0[0], r1[0], r0[1], r1[1]}; OUT = *reinterpret_cast<bf16x8*>(&w); } while (0)
  PK4(p0, 0, pa0); PK4(p0, 8, pa1); PK4(p1, 0, pa2); PK4(p1, 8, pa3);
#undef PK4
}
__device__ __forceinline__ void qkt(f32x16& p0, f32x16& p1, const bf16* Ks, const bf16x8* qr, int r32, int hi) {
  p0 = f32x16{}; p1 = f32x16{};
  for (int d0 = 0; d0 < 8; ++d0) { int cb = (d0 * 16 + hi * 8) * 2;
    bf16x8 b0 = *reinterpret_cast<const bf16x8*>((const char*)Ks + KSWZ(r32, cb));
    bf16x8 b1 = *reinterpret_cast<const bf16x8*>((const char*)Ks + KSWZ(32 + r32, cb));
    p0 = __builtin_amdgcn_mfma_f32_32x32x16_bf16(b0, qr[d0], p0, 0, 0, 0);
    p1 = __builtin_amdgcn_mfma_f32_32x32x16_bf16(b1, qr[d0], p1, 0, 0, 0); }
}
__device__ __forceinline__ void kmask(f32x16& p0, f32x16& p1, int k0, int klim, int hi) {
  if (k0 + 64 > klim) {
    if (k0 >= klim) {
#pragma unroll
      for (int r = 0; r < 16; ++r) { p0[r] = -1e30f; p1[r] = -1e30f; }
    } else {
#pragma unroll
      for (int r = 0; r < 16; ++r) { const int kk = k0 + crow(r, hi); if (kk >= klim) p0[r] = -1e30f; if (kk + 32 >= klim) p1[r] = -1e30f; }
    }
  }
}
__device__ __forceinline__ int v_st(int k, int c) { const int kk = (k & ~0xC) | ((k & 4) << 1) | ((k & 8) >> 1); return ((kk >> 3) * 4 + (c >> 5)) * 512 + ((kk & 7) * 32 + (c & 31)) * 2; }
__device__ __forceinline__ int v_rd_base(int lane) { return ((lane & 3) << 3) | (((lane >> 2) & 3) << 6) | (((lane >> 4) & 1) << 5) | (((lane >> 5) & 1) << 8); }
constexpr int v_rd_off(int d0, int ks, int half) { return d0 * 512 + ks * 4096 + half * 2048; }
template <int OFF> __device__ __forceinline__ s16x4 tr_read(int vb) {
  s16x4 r; asm volatile("ds_read_b64_tr_b16 %0, %1 offset:%2" : "=&v"(r) : "v"(vb), "i"(OFF) : "memory"); return r;
}
template <int D0> __device__ __forceinline__ void pv_one(f32x16& od, int vb, bf16x8 pa0, bf16x8 pa1, bf16x8 pa2, bf16x8 pa3) {
  const s16x4 l0 = tr_read<v_rd_off(D0, 0, 0)>(vb), h0 = tr_read<v_rd_off(D0, 0, 1)>(vb), l1 = tr_read<v_rd_off(D0, 1, 0)>(vb), h1 = tr_read<v_rd_off(D0, 1, 1)>(vb);
  const s16x4 l2 = tr_read<v_rd_off(D0, 2, 0)>(vb), h2 = tr_read<v_rd_off(D0, 2, 1)>(vb), l3 = tr_read<v_rd_off(D0, 3, 0)>(vb), h3 = tr_read<v_rd_off(D0, 3, 1)>(vb);
  asm volatile("s_waitcnt lgkmcnt(0)" ::: "memory"); SBAR();
#define PK(L, H) (bf16x8){L[0], L[1], L[2], L[3], H[0], H[1], H[2], H[3]}
  od = __builtin_amdgcn_mfma_f32_32x32x16_bf16(pa0, PK(l0, h0), od, 0, 0, 0);
  od = __builtin_amdgcn_mfma_f32_32x32x16_bf16(pa1, PK(l1, h1), od, 0, 0, 0);
  od = __builtin_amdgcn_mfma_f32_32x32x16_bf16(pa2, PK(l2, h2), od, 0, 0, 0);
  od = __builtin_amdgcn_mfma_f32_32x32x16_bf16(pa3, PK(l3, h3), od, 0, 0, 0);
#undef PK
}
__device__ __forceinline__ void pv_d0(f32x16* o, int vb, bf16x8 pa0, bf16x8 pa1, bf16x8 pa2, bf16x8 pa3) {
  pv_one<0>(o[0], vb, pa0, pa1, pa2, pa3); pv_one<1>(o[1], vb, pa0, pa1, pa2, pa3); pv_one<2>(o[2], vb, pa0, pa1, pa2, pa3); pv_one<3>(o[3], vb, pa0, pa1, pa2, pa3);
}

template <bool SAMPLE, bool COMPUTE>
__device__ __forceinline__ void attn_body_impl(const bf16* __restrict__ Qb, const bf16* __restrict__ Kh, const bf16* __restrict__ Vh, bf16* __restrict__ Ob, int seq, int klim0, char* lds) {
  const int tid = threadIdx.x, wid = __builtin_amdgcn_readfirstlane(tid >> 6), lane = tid & 63, r32 = lane & 31, hi = lane >> 5;
  const int klim = SAMPLE ? (wid == 0 ? klim0 : 0) : klim0 + 64 * (wid >> 1);
  bf16* V_lds = (bf16*)lds; bf16* K_lds = (bf16*)(lds + 2 * SHM_V);
  float* ws = (float*)(lds + 2 * SHM_V + 2 * SHM_K) + wid * 64; float* li_l = ws; float* al_l = ws + 32;
  float m_reg = -1e30f, l_reg = 0; f32x16 o[4] = {}; bf16x8 qr[8];
  const int qrow = SAMPLE ? (r32 & 15) : (wid * QBLK + r32);
  const bf16* Qw = Qb + (long)qrow * LDX + hi * 8;
#pragma unroll
  for (int d0 = 0; d0 < 8; ++d0) qr[d0] = *reinterpret_cast<const bf16x8*>(Qw + d0 * 16);
  const int sr = tid >> 4, sc = (tid & 15) * 8, vst0 = v_st(sr, sc), vst1 = v_st(32 + sr, sc);
  const int vb0 = (int)(uintptr_t)V_lds + v_rd_base(lane);
  constexpr int SDEPTH = 1;
  struct { bf16x8 vs0, vs1, ks0, ks1; } sr_[SDEPTH];
#define SLOAD(i, k0) do { sr_[i].vs0 = *reinterpret_cast<const bf16x8*>(&Vh[(long)((k0) + sr) * LDX + sc]); sr_[i].vs1 = *reinterpret_cast<const bf16x8*>(&Vh[(long)((k0) + 32 + sr) * LDX + sc]); \
    sr_[i].ks0 = *reinterpret_cast<const bf16x8*>(&Kh[(long)((k0) + sr) * LDX + sc]); sr_[i].ks1 = *reinterpret_cast<const bf16x8*>(&Kh[(long)((k0) + 32 + sr) * LDX + sc]); } while (0)
#define SWRITE(b, i) do { *(bf16x8*)((char*)V_lds + (b) * SHM_V + vst0) = sr_[i].vs0;          \
    *(bf16x8*)((char*)V_lds + (b) * SHM_V + vst1) = sr_[i].vs1; int kc = sc * 2;               \
    *(bf16x8*)((char*)K_lds + (b) * SHM_K + KSWZ(sr, kc)) = sr_[i].ks0;                       \
    *(bf16x8*)((char*)K_lds + (b) * SHM_K + KSWZ(32 + sr, kc)) = sr_[i].ks1; } while (0)
#define SWAIT() do { if constexpr (SDEPTH == 2) asm volatile("s_waitcnt vmcnt(4)" ::: "memory"); else asm volatile("s_waitcnt vmcnt(0)" ::: "memory"); } while (0)
#define RESC(a) do { if (__any((a) < 1.f)) { if (hi == 0) al_l[r32] = (a); asm volatile("s_waitcnt lgkmcnt(0)" ::: "memory"); \
    for (int d = 0; d < 4; ++d) for (int r = 0; r < 16; ++r) o[d][r] *= al_l[crow(r, hi)]; } } while (0)
  f32x16 pA0, pA1, pB0, pB1; float mnA, mnB, alA = 1.f, alB = 1.f; bf16x8 pa0, pa1, pa2, pa3; const int NT = seq / KVBLK;
  constexpr int SE = 0, SO = SDEPTH - 1;
  SLOAD(SE, 0); asm volatile("s_waitcnt vmcnt(0)" ::: "memory"); SWRITE(0, SE); __syncthreads();
  if constexpr (COMPUTE) { qkt(pA0, pA1, K_lds, qr, r32, hi); kmask(pA0, pA1, 0, klim, hi); partialSM(pA0, pA1, m_reg, mnA, alA); }
  SLOAD(SO, KVBLK); if constexpr (SDEPTH == 2) { if (2 < NT) SLOAD(SE, 2 * KVBLK); }
  SWAIT(); SWRITE(1, SO); __syncthreads();
  for (int j = 1; j + 1 < NT; j += 2) {
    SBAR();
    if constexpr (COMPUTE) { qkt(pB0, pB1, (bf16*)((char*)K_lds + SHM_K), qr, r32, hi); kmask(pB0, pB1, j * KVBLK, klim, hi);
      finishSM(pA0, pA1, alA, l_reg, pa0, pa1, pa2, pa3); }
    SBAR();
    SLOAD(SO, (j + SDEPTH) * KVBLK); SBAR();
    if constexpr (COMPUTE) { pv_d0(o, vb0, pa0, pa1, pa2, pa3); partialSM(pB0, pB1, m_reg, mnB, alB); }
    __syncthreads(); SWAIT(); SWRITE(0, SE);
    if constexpr (COMPUTE) { RESC(alB); } __syncthreads();
    SBAR();
    if constexpr (COMPUTE) { qkt(pA0, pA1, K_lds, qr, r32, hi); kmask(pA0, pA1, (j + 1) * KVBLK, klim, hi);
      finishSM(pB0, pB1, alB, l_reg, pa0, pa1, pa2, pa3); }
    SBAR();
    if (SDEPTH == 1 || j + 3 < NT) SLOAD(SE, (j + 1 + SDEPTH) * KVBLK); SBAR();
    if constexpr (COMPUTE) { pv_d0(o, vb0 + (int)SHM_V, pa0, pa1, pa2, pa3); partialSM(pA0, pA1, m_reg, mnA, alA); }
    __syncthreads(); SWAIT(); SWRITE(1, SO);
    if constexpr (COMPUTE) { RESC(alA); } __syncthreads();
  }
  SBAR();
  if constexpr (COMPUTE) { qkt(pB0, pB1, (bf16*)((char*)K_lds + SHM_K), qr, r32, hi); kmask(pB0, pB1, (NT - 1) * KVBLK, klim, hi);
    finishSM(pA0, pA1, alA, l_reg, pa0, pa1, pa2, pa3); }
  SBAR();
  if constexpr (COMPUTE) { pv_d0(o, vb0, pa0, pa1, pa2, pa3); partialSM(pB0, pB1, m_reg, mnB, alB); }
  __syncthreads();
  if constexpr (COMPUTE) { RESC(alB);
    finishSM(pB0, pB1, alB, l_reg, pa0, pa1, pa2, pa3); SBAR();
    pv_d0(o, vb0 + (int)SHM_V, pa0, pa1, pa2, pa3);
    if (hi == 0) li_l[r32] = l_reg; asm volatile("s_waitcnt lgkmcnt(0)" ::: "memory");
    float rli[16];
#pragma unroll
    for (int r = 0; r < 16; ++r) rli[r] = __builtin_amdgcn_rcpf(li_l[crow(r, hi)]);
    bf16* Ow = Ob + (long)(SAMPLE ? 0 : wid * QBLK) * LDX;
#pragma unroll
    for (int r = 0; r < 16; ++r) { const int orow = crow(r, hi);
      if (!SAMPLE || (orow < 16 && wid == 0)) {
#pragma unroll
        for (int d0 = 0; d0 < 4; ++d0) Ow[(long)orow * LDX + d0 * 32 + r32] = __float2bfloat16(o[d0][r] * rli[r]); } }
  }
  __syncthreads();
#undef SLOAD
#undef SWRITE
#undef SWAIT
#undef RESC
}
template <bool SAMPLE>
__device__ __forceinline__ void attn_body(const bf16* __restrict__ Qb, const bf16* __restrict__ Kh, const bf16* __restrict__ Vh, bf16* __restrict__ Ob, int seq, int klim0, char* lds) {
  attn_body_impl<SAMPLE, true>(Qb, Kh, Vh, Ob, seq, klim0, lds);
}
#undef KSWZ
#undef SBAR
}


#define GAS __attribute__((address_space(1)))
#define LAS __attribute__((address_space(3)))
typedef unsigned short bf16;
typedef unsigned v4u __attribute__((ext_vector_type(4)));
typedef float f32x4 __attribute__((ext_vector_type(4)));
typedef short bf16x8 __attribute__((ext_vector_type(8)));
typedef GAS unsigned gu32;
typedef GAS unsigned long long gu64;
#define RLX_AGENT __ATOMIC_RELAXED, __HIP_MEMORY_SCOPE_AGENT
#define LDS_WAIT() asm volatile("s_waitcnt lgkmcnt(0)" ::: "memory")
#define VM_WAIT() asm volatile("s_waitcnt vmcnt(0)" ::: "memory")
__device__ __forceinline__ unsigned long long rt() { return __builtin_amdgcn_s_memrealtime(); }
__device__ __forceinline__ unsigned f2bf(float f) { unsigned u = __builtin_bit_cast(unsigned, f); return (u + 0x7fffu + ((u >> 16) & 1u)) >> 16; }
__device__ __forceinline__ unsigned pk2(float lo, float hi) { return f2bf(lo) | (f2bf(hi) << 16); }

#define XB_TMO      128
#define XB_XCNT(j)  (256  + 64 * (j))
#define XB_XSUB(j)  (1280 + 64 * (j))
#define XB_XGEN(j)  (2304 + 64 * (j))
#define XB_TOP      3328
#define XB_TOPGEN   3392
#define XCD_BAR_WORDS 3456
#define XB_SPIN_CAP (1u << 18)

__device__ __forceinline__ unsigned xb_ld(unsigned* p)              { return __hip_atomic_load(p, __ATOMIC_RELAXED, __HIP_MEMORY_SCOPE_AGENT); }
__device__ __forceinline__ unsigned xb_add(unsigned* p, unsigned v) { return __hip_atomic_fetch_add(p, v, __ATOMIC_RELAXED, __HIP_MEMORY_SCOPE_AGENT); }
__device__ __forceinline__ unsigned xb_xcc_id() { return (unsigned)__builtin_amdgcn_s_getreg((3 << 11) | 20) & 0xFu; }
#define XB_SPIN(cond, bar) do { unsigned _sp = 0; while (cond) { __builtin_amdgcn_s_sleep(1); \
    if ((++_sp & 255u) == 0u) { if (xb_ld(&(bar)[XB_TMO])) break; if (_sp > XB_SPIN_CAP) { atomicAdd(&(bar)[XB_TMO], 1u); break; } } } } while (0)

struct XcdBarrier {
    unsigned* bar; unsigned x; int w;
    volatile LAS unsigned* st;
};

__device__ __forceinline__ XcdBarrier xcd_barrier_post(unsigned* bar, volatile LAS unsigned* st, int w) {
    XcdBarrier b; b.bar = bar; b.x = xb_xcc_id(); b.st = st; b.w = w;
    if (w == 0 && hw_lane() == 0) (void)xb_add(&bar[XB_XCNT(b.x)], 1u);
    return b;
}
__device__ __forceinline__ void xcd_barrier_complete(unsigned* bar, unsigned x, unsigned& nloc, unsigned& nx) {
    const unsigned G = gridDim.x * gridDim.y * gridDim.z;
    unsigned sum, cnt, mine, sp = 0u;
    for (;;) {
        sum = 0u; cnt = 0u; mine = 0u;
#pragma unroll
        for (unsigned j = 0; j < 16; ++j) { const unsigned c = xb_ld(&bar[XB_XCNT(j)]); sum += c; cnt += (c > 0u) ? 1u : 0u; mine = (j == x) ? c : mine; }
        if (sum == G) break;
        __builtin_amdgcn_s_sleep(1);
        if ((++sp & 255u) == 0u) { if (xb_ld(&bar[XB_TMO])) break; if (sp > XB_SPIN_CAP) { atomicAdd(&bar[XB_TMO], 1u); break; } }
    }
    nloc = mine > 0u ? mine : 1u; nx = cnt > 0u ? cnt : 1u;
}

__device__ __forceinline__ void xcd_barrier(const XcdBarrier& b) {
    asm volatile("s_waitcnt vmcnt(0)" ::: "memory");
    __syncthreads();
    if (b.w == 0 && hw_lane() == 0) {
        unsigned* bar = b.bar;
        __builtin_amdgcn_s_waitcnt(0);
        unsigned nloc = b.st[0], nx = b.st[1];
        if (nloc == 0u) { xcd_barrier_complete(bar, b.x, nloc, nx); b.st[0] = nloc; b.st[1] = nx; }
        const unsigned old = xb_add(&bar[XB_XSUB(b.x)], 1u);
        const unsigned gen = old / nloc;
        if (old + 1u == (gen + 1u) * nloc) {
            __builtin_amdgcn_fence(__ATOMIC_RELEASE, "agent");
            asm volatile("s_waitcnt vmcnt(0)" ::: "memory");
            const unsigned og = xb_add(&bar[XB_TOP], 1u);
            const unsigned tg = og / nx;
            if (og + 1u == (tg + 1u) * nx) xb_add(&bar[XB_TOPGEN], 1u);
            else XB_SPIN(xb_ld(&bar[XB_TOPGEN]) == tg, bar);
            __builtin_amdgcn_fence(__ATOMIC_ACQUIRE, "agent");
            xb_add(&bar[XB_XGEN(b.x)], 1u);
            asm volatile("s_waitcnt vmcnt(0)" ::: "memory");
        } else {
            XB_SPIN(xb_ld(&bar[XB_XGEN(b.x)]) == gen, bar);
            __builtin_amdgcn_fence(__ATOMIC_ACQUIRE, "agent");
            asm volatile("s_waitcnt vmcnt(0)" ::: "memory");
        }
    }
    __syncthreads();
}

namespace att2 {
using att::bf16; using att::bf16x8; using att::s16x4; using att::f32x16; using att::u32x4; using att::crow;
constexpr int LDX = 2048, KBYTES = 16384, VBYTES = 32768;
constexpr int L_K = 0, L_V = 2 * KBYTES, L_WS = 2 * KBYTES + 2 * VBYTES, L_TOTAL = L_WS + 8 * 64 * 4;
#define A2_KSWZ(row, colB) ((row) * 256 + ((colB) ^ (((row) & 7) << 4)))
#define A2_SBAR() __builtin_amdgcn_sched_barrier(0)
template <int OFF> __device__ __forceinline__ s16x4 tr_read(int vb) {
  s16x4 r; asm volatile("ds_read_b64_tr_b16 %0, %1 offset:%2" : "=&v"(r) : "v"(vb), "i"(OFF) : "memory"); return r;
}
#define A2_TRR(dst, OFF) asm volatile("ds_read_b64_tr_b16 %0, %1 offset:%2" : "=&v"(dst) : "v"(vb), "i"(OFF) : "memory")
#define A2_BOFF(D0) (((D0) >> 2) * 16384 + ((D0) & 3) * 512)
#define A2_LOADBLK(X, D0) do { A2_TRR(X##l0, A2_BOFF(D0)); A2_TRR(X##h0, A2_BOFF(D0) + 2048); A2_TRR(X##l1, A2_BOFF(D0) + 4096); A2_TRR(X##h1, A2_BOFF(D0) + 4096 + 2048); \
    A2_TRR(X##l2, A2_BOFF(D0) + 8192); A2_TRR(X##h2, A2_BOFF(D0) + 8192 + 2048); A2_TRR(X##l3, A2_BOFF(D0) + 12288); A2_TRR(X##h3, A2_BOFF(D0) + 12288 + 2048); } while (0)
#define A2_PK(L, H) (bf16x8){L[0], L[1], L[2], L[3], H[0], H[1], H[2], H[3]}
#define A2_MMA4(od, X) do { od = __builtin_amdgcn_mfma_f32_32x32x16_bf16(pa0, A2_PK(X##l0, X##h0), od, 0, 0, 0); od = __builtin_amdgcn_mfma_f32_32x32x16_bf16(pa1, A2_PK(X##l1, X##h1), od, 0, 0, 0); \
    od = __builtin_amdgcn_mfma_f32_32x32x16_bf16(pa2, A2_PK(X##l2, X##h2), od, 0, 0, 0); od = __builtin_amdgcn_mfma_f32_32x32x16_bf16(pa3, A2_PK(X##l3, X##h3), od, 0, 0, 0); } while (0)
#define A2_WAITL(n) do { asm volatile("s_waitcnt lgkmcnt(" #n ")" ::: "memory"); A2_SBAR(); } while (0)
#define A2_KRD(A, B, D0) do { const int ad_ = kaddr + (((D0) << 5) ^ kx); asm volatile("ds_read_b128 %0, %1" : "=&v"(A) : "v"(ad_) : "memory"); \
    asm volatile("ds_read_b128 %0, %1 offset:8192" : "=&v"(B) : "v"(ad_) : "memory"); } while (0)
#define A2_KMM(A, B, D0) do { p0 = __builtin_amdgcn_mfma_f32_32x32x16_bf16(A, qr[D0], p0, 0, 0, 0); p1 = __builtin_amdgcn_mfma_f32_32x32x16_bf16(B, qr[D0], p1, 0, 0, 0); A2_SBAR(); } while (0)
__device__ __forceinline__ void qkt3(f32x16& p0, f32x16& p1, int kaddr, const bf16x8* qr, int kx, float negm) {
  asm volatile("" : "+v"(kx));
  bf16x8 a0, b0, a1, b1, a2, b2;
  A2_KRD(a0, b0, 0); A2_KRD(a1, b1, 1); A2_KRD(a2, b2, 2);
#pragma unroll
  for (int r = 0; r < 16; ++r) { p0[r] = negm; p1[r] = negm; }
  A2_WAITL(4); A2_KMM(a0, b0, 0); A2_KRD(a0, b0, 3);
  A2_WAITL(4); A2_KMM(a1, b1, 1); A2_KRD(a1, b1, 4);
  A2_WAITL(4); A2_KMM(a2, b2, 2); A2_KRD(a2, b2, 5);
  A2_WAITL(4); A2_KMM(a0, b0, 3); A2_KRD(a0, b0, 6);
  A2_WAITL(4); A2_KMM(a1, b1, 4); A2_KRD(a1, b1, 7);
  A2_WAITL(4); A2_KMM(a2, b2, 5);
  A2_WAITL(2); A2_KMM(a0, b0, 6);
  A2_WAITL(0); A2_KMM(a1, b1, 7);
}
#define A2_WAITV(n) asm volatile("s_waitcnt vmcnt(" #n ")" ::: "memory")
#define A2_BAR() do { asm volatile("s_waitcnt lgkmcnt(0)" ::: "memory"); __builtin_amdgcn_s_barrier(); asm volatile("" ::: "memory"); } while (0)

__device__ __forceinline__ void sm1(f32x16& p0, f32x16& p1, float& negm, float& alpha, float& l_reg, unsigned (&w)[16], bool first) {
  constexpr float THRL = att::THR * 1.4426950408889634f;
  float pmax = p0[0];
#pragma unroll
  for (int r = 1; r < 16; ++r) pmax = fmaxf(pmax, p0[r]);
#pragma unroll
  for (int r = 0; r < 16; ++r) pmax = fmaxf(pmax, p1[r]);
  { auto rr = __builtin_amdgcn_permlane32_swap(__float_as_uint(pmax), __float_as_uint(pmax), false, false);
    pmax = fmaxf(__uint_as_float(rr[0]), __uint_as_float(rr[1])); }
  alpha = 1.f;
  if (__builtin_expect(first || !__all(pmax <= THRL), 0)) {
    const float dl = first ? pmax : fmaxf(pmax, 0.f);
#pragma unroll
    for (int r = 0; r < 16; ++r) { p0[r] -= dl; p1[r] -= dl; }
    negm -= dl;
    alpha = __builtin_amdgcn_exp2f(-dl);
  }
#pragma unroll
  for (int r = 0; r < 16; ++r) p0[r] = __builtin_amdgcn_exp2f(p0[r]);
#pragma unroll
  for (int r = 0; r < 16; ++r) p1[r] = __builtin_amdgcn_exp2f(p1[r]);
  float s0 = 0.f, s1 = 0.f;
#pragma unroll
  for (int r = 0; r < 16; ++r) { s0 += p0[r]; s1 += p1[r]; }
  float ps = s0 + s1;
  { auto rr = __builtin_amdgcn_permlane32_swap(__float_as_uint(ps), __float_as_uint(ps), false, false);
    ps = __uint_as_float(rr[0]) + __uint_as_float(rr[1]); }
  l_reg = l_reg * alpha + ps;
#pragma unroll
  for (int i = 0; i < 8; ++i) { w[i] = att::cvtpk(p0[2 * i], p0[2 * i + 1]); w[8 + i] = att::cvtpk(p1[2 * i], p1[2 * i + 1]); }
}
__device__ __forceinline__ void sm2(const unsigned (&w)[16], bf16x8& pa0, bf16x8& pa1, bf16x8& pa2, bf16x8& pa3) {
#define PK4(B, OUT) do { auto r0 = __builtin_amdgcn_permlane32_swap(w[B + 0], w[B + 2], false, false); auto r1 = __builtin_amdgcn_permlane32_swap(w[B + 1], w[B + 3], false, false); \
    u32x4 x = {r0[0], r1[0], r0[1], r1[1]}; OUT = *reinterpret_cast<bf16x8*>(&x); } while (0)
  PK4(0, pa0); PK4(4, pa1); PK4(8, pa2); PK4(12, pa3);
#undef PK4
}

template <bool SAMPLE>
__device__ __forceinline__ void attn256(const bf16* __restrict__ Qb, const bf16* __restrict__ Kh, const bf16* __restrict__ Vh, bf16* __restrict__ Ob, int NT, int klim0,
                                        LAS unsigned char* ldsl, char* lds, int tid_in) {
  int tid = tid_in; asm volatile("" : "+v"(tid));
  const int wid = __builtin_amdgcn_readfirstlane(tid >> 6), lane = tid & 63, r32 = lane & 31, hi = lane >> 5;
  const bool grpB = wid >= 4;
  const int klim = SAMPLE ? (wid == 0 ? klim0 : 0) : klim0 + 64 * (wid >> 1);
  float* wsf = (float*)(lds + L_WS) + wid * 64; float* li_l = wsf; float* al_l = wsf + 32;
  const unsigned voK0 = (unsigned)(((lane >> 4) << 8) + (((lane & 15) ^ (lane >> 4)) << 4));
  const int vx_ = (lane & 31) >> 2;
  const unsigned voV = (unsigned)((((vx_ & 3) + ((vx_ & 4) << 1)) << 9) + ((32 * (lane >> 5) + 8 * (lane & 3)) << 1));
#define DMA_KP(t, buf, i) do { const int ch_ = 4 * (wid & 3) + (i); \
      __builtin_amdgcn_global_load_lds((const unsigned*)((const char*)Kh + ((size_t)(t) * 16384 + ch_ * 1024) + (voK0 ^ (unsigned)((ch_ & 3) << 6))), (LAS unsigned*)(ldsl + L_K + (buf) * KBYTES + ch_ * 1024), 16, 0, 0); } while (0)
#define DMA_VP(t, buf, i) do { const int hh_ = (wid & 3) >> 1, q_ = 8 * (wid & 1) + (i); \
      __builtin_amdgcn_global_load_lds((const unsigned*)((const char*)Vh + ((size_t)(t) * 32768 + ((((q_ >> 1) & 1) * 4 + (q_ >> 2) * 16) << 9) + ((128 * hh_ + 64 * (q_ & 1)) << 1)) + voV), \
                                       (LAS unsigned*)(ldsl + L_V + (buf) * VBYTES + hh_ * 16384 + q_ * 1024), 16, 0, 0); } while (0)
  bf16x8 qr[8];
  { const int qrow = SAMPLE ? (r32 & 15) : (wid * 32 + r32); const bf16* Qw = Qb + (long)qrow * LDX + hi * 8;
#pragma unroll
    for (int d0 = 0; d0 < 8; ++d0) { const u32x4 raw = *reinterpret_cast<const u32x4*>(Qw + d0 * 16); u32x4 sc;
      constexpr float QC = att::SCALE * 1.4426950408889634f;
#pragma unroll
      for (int e = 0; e < 4; ++e) sc[e] = att::cvtpk(__uint_as_float(raw[e] << 16) * QC, __uint_as_float(raw[e] & 0xffff0000u) * QC);
      qr[d0] = *reinterpret_cast<bf16x8*>(&sc); } }
  asm volatile("" ::: "memory");
  if (grpB) { DMA_KP(0, 0, 0); DMA_KP(0, 0, 1); DMA_KP(0, 0, 2); DMA_KP(0, 0, 3); }
  else { DMA_VP(0, 0, 0); DMA_VP(0, 0, 1); DMA_VP(0, 0, 2); DMA_VP(0, 0, 3); DMA_VP(0, 0, 4); DMA_VP(0, 0, 5); DMA_VP(0, 0, 6); DMA_VP(0, 0, 7); }
  float l_reg = 0.f, negm = 0.f; f32x16 o[8];
#pragma unroll
  for (int d = 0; d < 8; ++d) o[d] = f32x16{};
  const int vb0 = (int)(uintptr_t)(lds + L_V) + att::v_rd_base(lane);
  const int kaddr0 = (int)(uintptr_t)(lds + L_K) + r32 * 256;
  float alpha = 1.f;
  if (grpB) A2_WAITV(0);
  A2_BAR();
  if (grpB) { if (1 < NT) { DMA_KP(1, 1, 0); DMA_KP(1, 1, 1); DMA_KP(1, 1, 2); DMA_KP(1, 1, 3); } A2_BAR(); }
  int jfirst = 0; asm volatile("" : "+s"(jfirst));
#pragma nounroll
  for (int j = 0; j < NT; ++j) {
    const bool vis = j * 64 < klim;
    unsigned pw[16];
    if (vis) {
      f32x16 p0, p1;
      qkt3(p0, p1, kaddr0 + (j & 1) * KBYTES, qr, (hi << 4) ^ ((r32 & 15) << 4), negm);
      if (SAMPLE) att::kmask(p0, p1, j * 64, klim, hi);
      sm1(p0, p1, negm, alpha, l_reg, pw, j == jfirst);
    }
    A2_WAITV(0);
    A2_BAR();
    const bool dmaV = !grpB && (j + 1 < NT), dmaK = grpB && (j + 2 < NT);
#define A2_HOOK(g) do { if (dmaV) { DMA_VP(j + 1, (j + 1) & 1, g); } else if (dmaK && (((g) & 1) == 0)) { DMA_KP(j + 2, j & 1, (g) >> 1); } A2_SBAR(); } while (0)
    if (vis) {
      if (__any(alpha < 1.f)) { if (hi == 0) al_l[r32] = alpha; asm volatile("s_waitcnt lgkmcnt(0)" ::: "memory");
#pragma unroll
        for (int d = 0; d < 8; ++d)
#pragma unroll
          for (int r = 0; r < 16; ++r) o[d][r] *= al_l[crow(r, hi)];
        asm volatile("s_waitcnt lgkmcnt(0)" ::: "memory"); }
      const int vb = vb0 + (j & 1) * VBYTES;
      s16x4 Al0, Ah0, Al1, Ah1, Al2, Ah2, Al3, Ah3, Bl0, Bh0, Bl1, Bh1, Bl2, Bh2, Bl3, Bh3;
      A2_SBAR();
      bf16x8 pa0, pa1, pa2, pa3;
      sm2(pw, pa0, pa1, pa2, pa3);
      A2_SBAR();
      A2_LOADBLK(A, 0); A2_LOADBLK(B, 1); A2_WAITL(8); A2_MMA4(o[0], A); A2_SBAR(); A2_HOOK(0);
      A2_LOADBLK(A, 2); A2_WAITL(8); A2_MMA4(o[1], B); A2_SBAR(); A2_HOOK(1);
      A2_LOADBLK(B, 3); A2_WAITL(8); A2_MMA4(o[2], A); A2_SBAR(); A2_HOOK(2);
      A2_LOADBLK(A, 4); A2_WAITL(8); A2_MMA4(o[3], B); A2_SBAR(); A2_HOOK(3);
      A2_LOADBLK(B, 5); A2_WAITL(8); A2_MMA4(o[4], A); A2_SBAR(); A2_HOOK(4);
      A2_LOADBLK(A, 6); A2_WAITL(8); A2_MMA4(o[5], B); A2_SBAR(); A2_HOOK(5);
      A2_LOADBLK(B, 7); A2_WAITL(8); A2_MMA4(o[6], A); A2_SBAR(); A2_HOOK(6);
      A2_WAITL(0); A2_MMA4(o[7], B); A2_SBAR(); A2_HOOK(7);
    } else {
      A2_HOOK(0); A2_HOOK(1); A2_HOOK(2); A2_HOOK(3); A2_HOOK(4); A2_HOOK(5); A2_HOOK(6); A2_HOOK(7);
    }
#undef A2_HOOK
    A2_BAR();
  }
  {
    const int le_ = hw_lane(), r32 = le_ & 31, hi = le_ >> 5;
    if (hi == 0) li_l[r32] = l_reg; asm volatile("s_waitcnt lgkmcnt(0)" ::: "memory");
    float rli[16];
#pragma unroll
    for (int r = 0; r < 16; ++r) rli[r] = __builtin_amdgcn_rcpf(li_l[crow(r, hi)]);
    bf16* Ow = Ob + (long)(SAMPLE ? 0 : wid * 32) * LDX;
#pragma unroll
    for (int r = 0; r < 16; ++r) { const int orow = crow(r, hi);
      if (!SAMPLE || (orow < 16 && wid == 0)) {
#pragma unroll
        for (int d0 = 0; d0 < 8; ++d0) Ow[(long)orow * LDX + d0 * 32 + r32] = __float2bfloat16(o[d0][r] * rli[r]); } }
  }
  if (!grpB) A2_BAR();
#undef DMA_KP
#undef DMA_VP
}
#undef A2_KSWZ
}

__device__ __forceinline__ float wave_sum(float v) {
#pragma unroll
    for (int o = 1; o < 64; o <<= 1) v += __shfl_xor(v, o);
    return v;
}
__device__ __forceinline__ void tr_item(const float* W, int K, int N, bf16* WT, int ldk, int row_off, int mode, const float* gk, int gmod, float gmul, const float* sn,
                                        LAS float* scr, int item, int lane) {
    const int nblk = N / 32, kb = item / nblk, nb = item % nblk, k0 = 64 * kb, n0 = 32 * nb;
    const float sv = sn ? sn[n0 + (lane & 31)] : 1.0f;
#pragma unroll
    for (int i = 0; i < 32; ++i) { const int kk = 2 * i + (lane >> 5); const float g = gk ? gk[(k0 + kk) % gmod] * gmul : 1.0f;
        scr[kk * 33 + (lane & 31)] = W[(size_t)(k0 + kk) * N + n0 + (lane & 31)] * g * sv; }
    LDS_WAIT(); asm volatile("" ::: "memory");
    const int c = lane & 7;
#pragma unroll
    for (int j = 0; j < 4; ++j) { const int n = (lane >> 3) + 8 * j; const LAS float* s = scr + (8 * c) * 33 + n;
        v4u o; o.x = pk2(s[0 * 33], s[1 * 33]); o.y = pk2(s[2 * 33], s[3 * 33]); o.z = pk2(s[4 * 33], s[5 * 33]); o.w = pk2(s[6 * 33], s[7 * 33]);
        const int ng = n0 + n; int rw;
        if (mode == 0) rw = ng; else { const int jj = ng & 255; rw = (ng & ~255) + 128 * ((jj & 127) >> 6) + 64 * (jj >> 7) + (jj & 63); }
        *(GAS v4u*)(WT + (size_t)(row_off + rw) * ldk + k0 + 8 * c) = o; }
    LDS_WAIT(); asm volatile("" ::: "memory");
}

constexpr size_t CV_NCHUNK = (size_t)16 * SPAST * (D / 8), CV_NZ = (size_t)16 * (SKEYS - SLIM) * (D / 8), CV_ITEMS = 2 * CV_NCHUNK + 2 * CV_NZ;
__device__ __forceinline__ void conv_items(const float* cache_k, const float* cache_v, bf16* KS, bf16* VS, size_t q0, size_t q1, int tid_in) {
    for (size_t q = q0 + (unsigned)tid_in; q < q1; q += 512) {
        if (q < 2 * CV_NCHUNK) {
            const bool isv = q >= CV_NCHUNK; const size_t qq = isv ? q - CV_NCHUNK : q;
            const size_t row = qq >> 8; const int cc = (int)(qq & 255); const size_t b = row >> 12, p = row & 4095;
            const float* src = (isv ? cache_v : cache_k) + row * D + cc * 8;
            const f32x4 a = *(const f32x4*)src, c = *(const f32x4*)(src + 4);
            v4u o; o.x = pk2(a[0], a[1]); o.y = pk2(a[2], a[3]); o.z = pk2(c[0], c[1]); o.w = pk2(c[2], c[3]);
            const int col = cc * 8, h = col >> 8;
            if (isv) *(v4u*)(VS + ((b * 8 + h) * SKEYS + p) * 256 + (col & 255)) = o;
            else     *(v4u*)(KS + (((b * 8 + h) * 2 + ((col >> 7) & 1)) * SKEYS + p) * 128 + (col & 127)) = o;
        } else {
            const size_t z = q - 2 * CV_NCHUNK; const bool isv = z >= CV_NZ; const size_t qq = isv ? z - CV_NZ : z;
            const size_t row = qq >> 8; const int cc = (int)(qq & 255); const size_t b = row / (SKEYS - SLIM), p = SLIM + row % (SKEYS - SLIM);
            const int col = cc * 8, h = col >> 8;
            if (isv) *(v4u*)(VS + ((b * 8 + h) * SKEYS + p) * 256 + (col & 255)) = (v4u){0u, 0u, 0u, 0u};
            else     *(v4u*)(KS + (((b * 8 + h) * 2 + ((col >> 7) & 1)) * SKEYS + p) * 128 + (col & 127)) = (v4u){0u, 0u, 0u, 0u};
        }
    }
}
__device__ __forceinline__ void conv_filler(const float* cache_k, const float* cache_v, bf16* KS, bf16* VS, int nwg, int G, int c, int f0, int f1, int tid_in) {
    const int busy = nwg % G;
    const size_t j0 = CV_ITEMS / 128 * f0, j1 = (f1 == 128) ? CV_ITEMS : CV_ITEMS / 128 * f1;
    if (busy == 0) { const size_t per = (j1 - j0 + G - 1) / G, a = j0 + per * c, b = a + per < j1 ? a + per : j1; if (a < b) conv_items(cache_k, cache_v, KS, VS, a, b, tid_in); return; }
    if (c < busy) return;
    const int nidle = G - busy, ic = c - busy;
    const size_t per = (j1 - j0 + nidle - 1) / nidle, a = j0 + per * ic, b = a + per < j1 ? a + per : j1;
    if (a < b) conv_items(cache_k, cache_v, KS, VS, a, b, tid_in);
}

struct Args { const float* in[26]; float* out; unsigned char* ws; int ph_lo, ph_hi; };
static_assert(sizeof(Args) == 26 * 8 + 8 + 8 + 8, "Args has no padding");

__global__ void __launch_bounds__(NWAVES * 64, 2) yoco_fwd(Args args) {
    extern __shared__ __attribute__((aligned(16))) unsigned char lds[];
    LAS unsigned char* const ldsp = (LAS unsigned char*)lds;
    volatile LAS unsigned* const MISC = (volatile LAS unsigned*)(ldsp + MISC_OFF);
    const int wave = __builtin_amdgcn_readfirstlane(threadIdx.x >> 6);
#define lane (hw_lane())
#define tid (wave * 64 + hw_lane())
    const int G = gridDim.x; const int bx = blockIdx.x; const int vcu = (G % 8 == 0) ? (bx % 8) * (G / 8) + bx / 8 : bx;
    gu32* const ctl = (gu32*)(args.ws + WS_CTL);
    for (int u = tid; u < (LDS_BYTES - LDSCTL_OFF) / 4; u += NWAVES * 64) ((LAS unsigned*)(ldsp + LDSCTL_OFF))[u] = 0u;
    __syncthreads();
    XcdBarrier bar; bar.bar = (unsigned*)(ctl + CW_BAR); bar.x = 0; bar.st = nullptr; bar.w = wave;
    if (!MK_PER_PHASE) bar = xcd_barrier_post((unsigned*)(ctl + CW_BAR), MISC + 8, wave);
    const int lo = args.ph_lo, hi = args.ph_hi;
#ifndef PHASE_MASK
#define PHASE_MASK 0xFFFF
#endif
#define IN(k) (((PHASE_MASK >> (k)) & 1) && lo <= (k) && (k) < hi)
#define SEAM(k) do { if (IN(k) && IN((k) + 1)) xcd_barrier(bar); } while (0)
    const int gw = vcu * NWAVES + wave, NGW = G * NWAVES;
#define CAS __attribute__((address_space(4)))
#define ARGP() ({ const CAS Args* p_ = (const CAS Args*)__builtin_amdgcn_kernarg_segment_ptr(); asm volatile("" : "+s"(p_)); p_; })
#define DECL_IN(name, i) const float* const name = ap_->in[i]
#define DECL_WS(type, name, off) type* const name = (type*)(ap_->ws + (off))
    if (IN(0)) for (int rep_ = 0; rep_ < NREP(0); ++rep_) {
        if (rep_) xcd_barrier(bar);
        const CAS Args* const ap_ = ARGP(); float* const out = ap_->out; unsigned char* const ws = ap_->ws; (void)out; (void)ws;
        DECL_IN(cache_k, 4);
        DECL_IN(cache_v, 5);
        DECL_IN(norm_mix, 6);
        DECL_IN(pool_w, 7);
        DECL_IN(pool_scale, 8);
        DECL_IN(norm_kv, 9);
        DECL_IN(w_k, 10);
        DECL_IN(w_v, 11);
        DECL_IN(w_q, 12);
        DECL_IN(subln, 17);
        DECL_IN(w_o, 18);
        DECL_IN(norm_ffn, 19);
        DECL_IN(w_gate, 20);
        DECL_IN(w_up, 21);
        DECL_IN(w_down, 24);
        DECL_IN(x_prompt, 0);
        DECL_IN(x_sample, 1);
        DECL_WS(float, RINV0, WS_RINV0);
        DECL_WS(float, CS, WS_CS);
        DECL_WS(bf16, WPOOL, WS_WPOOL);
        DECL_WS(bf16, WQKV, WS_WQKV);
        DECL_WS(bf16, WO, WS_WO);
        DECL_WS(bf16, KS, WS_KS);
        DECL_WS(bf16, VS, WS_VS);

        LAS float* scr = (LAS float*)(ldsp + RING_OFF + wave * 16384);
        constexpr int I_POOL = 4 * (512 / 64) * (512 / 32), I_F = (D / 64) * (FF / 32), I_P = (D / 64) * (D / 32);
        constexpr int NITEMS = I_POOL + 6 * I_F + 4 * I_P;
        for (int it = gw; it < NITEMS; it += NGW) {
            int r = it;
            if (r < I_POOL) { const int g = r / (I_POOL / 4), ri = r % (I_POOL / 4);
                tr_item(pool_w + (size_t)g * 512 * 512, 512, 512, WPOOL, DBS, g * 512, 0, nullptr, 1, 1.f, pool_scale + g * 512, scr, ri, lane); continue; }
            r -= I_POOL;
            if (r < 6 * I_F) { const int which = r / I_F, ri = r % I_F, l = which / 3, kind = which % 3;
                bf16* dst = (bf16*)(ws + WS_WG0 + (size_t)which * WS_WSTEP);
                if (kind == 0) tr_item(w_gate + (size_t)l * D * FF, D, FF, dst, XBS, 0, 0, norm_ffn + l * D, D, 1.f, nullptr, scr, ri, lane);
                else if (kind == 1) tr_item(w_up + (size_t)l * D * FF, D, FF, dst, XBS, 0, 0, norm_ffn + l * D, D, 1.f, nullptr, scr, ri, lane);
                else tr_item(w_down + (size_t)l * FF * D, FF, D, dst, FFS, 0, 0, nullptr, 1, 1.f, nullptr, scr, ri, lane);
                continue; }
            r -= 6 * I_F;
            { const int which = r / I_P, ri = r % I_P;
                if (which == 0) tr_item(w_k, D, D, WQKV, XBS, 0, 1, norm_kv, D, 1.f, nullptr, scr, ri, lane);
                else if (which == 1) tr_item(w_v, D, D, WQKV, XBS, D, 0, norm_kv, D, 1.f, nullptr, scr, ri, lane);
                else if (which == 2) tr_item(w_q, D, D, WQKV, XBS, 2 * D, 1, norm_mix + D, D, 1.f, nullptr, scr, ri, lane);
                else tr_item(w_o, D, D, WO, XBS, 0, 0, subln, 256, 1.0f - LAM_INIT, nullptr, scr, ri, lane); }
        }
        for (int e = gw * 64 + lane; e < 16384 * 64; e += NGW * 64) {
            const int pos = e >> 6, i = e & 63;
            double inv = 1.0, bs = 0.8659643233600653; int k = i;
#pragma unroll
            for (int s = 0; s < 6; ++s) { if (k & 1) inv *= bs; bs *= bs; k >>= 1; }
            const double rev = (double)pos * inv * 0.15915494309189535;
            const float fr = (float)(rev - __builtin_rint(rev));
            CS[2 * (size_t)e] = __builtin_amdgcn_cosf(fr); CS[2 * (size_t)e + 1] = __builtin_amdgcn_sinf(fr);
        }
        for (int r = gw; r < R; r += NGW) {
            const float* src = (r < RP) ? x_prompt + (size_t)r * D : x_sample + (size_t)(r - RP) * D;
            float s = 0.f;
#pragma unroll
            for (int j = 0; j < 8; ++j) { const f32x4 v = *(const f32x4*)(src + 4 * lane + 256 * j); s += (v[0] * v[0] + v[1] * v[1]) + (v[2] * v[2] + v[3] * v[3]); }
            s = wave_sum(s);
            if (lane == 0) RINV0[r] = rsqrtf(s * (1.0f / D) + EPS);
        }
    }
    SEAM(0);

    if (IN(1)) for (int rep_ = 0; rep_ < NREP(1); ++rep_) {
        if (rep_) xcd_barrier(bar);
        const CAS Args* const ap_ = ARGP(); float* const out = ap_->out; unsigned char* const ws = ap_->ws; (void)out; (void)ws;
        DECL_IN(x_prompt, 0);
        DECL_IN(x_sample, 1);
        DECL_IN(cache_pool, 2);
        DECL_IN(norm_mix, 6);
        DECL_WS(float, RINV0, WS_RINV0);
        DECL_WS(bf16, DB, WS_DB);

        constexpr int NSTRIP = 512 + 16;
        for (int it = gw; it < NSTRIP * 8; it += NGW) {
            const int slab = it & 7, sidx = it >> 3;
            const int c = slab * 256 + lane * 4, g = slab >> 1, w = 2 << g;
            const bool samp = sidx >= 512;
            int b, t0, nrows; const float* xb; int rowbase;
            if (!samp) { b = sidx >> 8; t0 = (sidx & 255) * 64; nrows = 64; xb = x_prompt + (size_t)b * T * D; rowbase = b * T; }
            else { b = sidx - 512; t0 = 0; nrows = 16; xb = x_sample + (size_t)b * 16 * D; rowbase = RP + b * 16; }
            const f32x4 gn = *(const f32x4*)(norm_mix + c);
            const float* hp = cache_pool + (size_t)b * 15 * D + c;
#define HV(dst, t_) do { const int tq = (t_); if (tq >= 0) { const f32x4 v_ = *(const f32x4*)(xb + (size_t)tq * D + c); const float r_ = RINV0[rowbase + tq]; dst = v_ * r_ * gn; } \
                         else if (samp) dst = *(const f32x4*)(hp + (size_t)(15 + tq) * D); else dst = (f32x4){0.f, 0.f, 0.f, 0.f}; } while (0)
            f32x4 P = {0.f, 0.f, 0.f, 0.f};
            for (int j = 1; j < w; ++j) { f32x4 v; HV(v, t0 - j); P += v; }
#pragma unroll 8
            for (int i = 0; i < nrows; ++i) {
                const int t = t0 + i;
                f32x4 cur; HV(cur, t);
                const f32x4 S = P + cur;
                const int cnt = samp ? w : ((t + 1 < w) ? t + 1 : w);
                const f32x4 dd = S * (1.0f / (float)cnt) - cur;
                f32x4 old; HV(old, t - w + 1);
                P = S - old;
                const size_t row = (size_t)rowbase + t;
                unsigned long long pk = (unsigned long long)pk2(dd[0], dd[1]) | ((unsigned long long)pk2(dd[2], dd[3]) << 32);
                *(unsigned long long*)(DB + ((size_t)g * R + row) * DBS + (c & 511)) = pk;
                if (!samp) { if (t >= T - 15) *(f32x4*)(out + OFF_PS_P + ((size_t)b * 15 + (t - (T - 15))) * D + c) = cur; }
                else { if (t >= 1) *(f32x4*)(out + OFF_PS_S + ((size_t)b * 15 + (t - 1)) * D + c) = cur; }
            }
#undef HV
        }
    }
    SEAM(1);

    if (IN(2)) for (int rep_ = 0; rep_ < NREP(2); ++rep_) {
        if (rep_) xcd_barrier(bar);
        const CAS Args* const ap_ = ARGP(); float* const out = ap_->out; unsigned char* const ws = ap_->ws; (void)out; (void)ws;
        DECL_IN(x_prompt, 0);
        DECL_IN(x_sample, 1);
        DECL_WS(bf16, DB, WS_DB);
        DECL_WS(bf16, WPOOL, WS_WPOOL);
        DECL_WS(float, XA, WS_XA);
        DECL_WS(bf16, XB, WS_XB);
        DECL_WS(float, SS1, WS_SS);

        pg8::Gemm g{DB, WPOOL, R, D, 512, DBS, DBS, 2, (size_t)R * DBS}; pg8::StaticOrder S; S.init(R, D, G, bx);
        pg8::EpiResid E{x_prompt, x_sample, XA, XB, SS1};
        pg8::gemm_phase<pg8::EpiResid, pg8::StaticOrder, true, true>(ldsp + RING_OFF, g, S, E, tid);
        { DECL_IN(cache_k, 4); DECL_IN(cache_v, 5); DECL_WS(bf16, KS_f, WS_KS); DECL_WS(bf16, VS_f, WS_VS); conv_filler(cache_k, cache_v, KS_f, VS_f, (R / 256) * (D / 256), G, bx, 0, 8, tid); }
    }
    SEAM(2);
    if (IN(3)) for (int rep_ = 0; rep_ < NREP(3); ++rep_) {
        if (rep_) xcd_barrier(bar);
        const CAS Args* const ap_ = ARGP(); float* const out = ap_->out; unsigned char* const ws = ap_->ws; (void)out; (void)ws;
        DECL_WS(bf16, XB, WS_XB);
        DECL_WS(float, SS1, WS_SS);
        DECL_WS(bf16, GB, WS_GB);

        pg8::Gemm g{XB, (const bf16*)(ws + WS_WG0 + 0 * WS_WSTEP), R, FF, D, XBS, XBS, 1 << 30, 0}; pg8::StaticOrder S; S.init(R, FF, G, bx);
        pg8::EpiGate E{SS1, GB, out + OFF_FS_P, out + OFF_FS_S};
        pg8::gemm_phase<pg8::EpiGate, pg8::StaticOrder, true, true>(ldsp + RING_OFF, g, S, E, tid);
        { DECL_IN(cache_k, 4); DECL_IN(cache_v, 5); DECL_WS(bf16, KS_f, WS_KS); DECL_WS(bf16, VS_f, WS_VS); conv_filler(cache_k, cache_v, KS_f, VS_f, (R / 256) * (FF / 256), G, bx, 8, 30, tid); }
    }
    SEAM(3);
    if (IN(4)) for (int rep_ = 0; rep_ < NREP(4); ++rep_) {
        if (rep_) xcd_barrier(bar);
        const CAS Args* const ap_ = ARGP(); float* const out = ap_->out; unsigned char* const ws = ap_->ws; (void)out; (void)ws;
        DECL_IN(conv_w, 22);
        DECL_IN(conv_b, 23);
        DECL_IN(cache_ffn, 3);
        DECL_WS(bf16, XB, WS_XB);
        DECL_WS(float, SS1, WS_SS);
        DECL_WS(bf16, GB, WS_GB);
        DECL_WS(bf16, HB, WS_HB);

        pg8::Gemm g{XB, (const bf16*)(ws + WS_WG0 + 1 * WS_WSTEP), R, FF, D, XBS, XBS, 1 << 30, 0}; pg8::StaticOrder S; S.init(R, FF, G, bx);
        pg8::EpiUp E{SS1, GB, HB, conv_w, conv_b, cache_ffn};
        pg8::gemm_phase<pg8::EpiUp, pg8::StaticOrder, true, true>(ldsp + RING_OFF, g, S, E, tid);
        { DECL_IN(cache_k, 4); DECL_IN(cache_v, 5); DECL_WS(bf16, KS_f, WS_KS); DECL_WS(bf16, VS_f, WS_VS); conv_filler(cache_k, cache_v, KS_f, VS_f, (R / 256) * (FF / 256), G, bx, 30, 52, tid); }
    }
    SEAM(4);
    if (IN(5)) for (int rep_ = 0; rep_ < NREP(5); ++rep_) {
        if (rep_) xcd_barrier(bar);
        const CAS Args* const ap_ = ARGP(); float* const out = ap_->out; unsigned char* const ws = ap_->ws; (void)out; (void)ws;
        DECL_WS(bf16, HB, WS_HB);
        DECL_WS(float, XA, WS_XA);
        DECL_WS(bf16, XB, WS_XB);
        DECL_WS(float, SS2, WS_SS + SS_BYTES);

        pg8::Gemm g{HB, (const bf16*)(ws + WS_WG0 + 2 * WS_WSTEP), R, D, FF, FFS, FFS, 1 << 30, 0}; pg8::StaticOrder S; S.init(R, D, G, bx);
        pg8::EpiResid E{XA, XA + (size_t)RP * D, XA, XB, SS2};
        pg8::gemm_phase<pg8::EpiResid, pg8::StaticOrder, true, true>(ldsp + RING_OFF, g, S, E, tid);
        { DECL_IN(cache_k, 4); DECL_IN(cache_v, 5); DECL_WS(bf16, KS_f, WS_KS); DECL_WS(bf16, VS_f, WS_VS); conv_filler(cache_k, cache_v, KS_f, VS_f, (R / 256) * (D / 256), G, bx, 52, 106, tid); }
    }
    SEAM(5);
    if (IN(6)) for (int rep_ = 0; rep_ < NREP(6); ++rep_) {
        if (rep_) xcd_barrier(bar);
        const CAS Args* const ap_ = ARGP(); float* const out = ap_->out; unsigned char* const ws = ap_->ws; (void)out; (void)ws;
        DECL_WS(bf16, XB, WS_XB);
        DECL_WS(bf16, WQKV, WS_WQKV);
        DECL_WS(float, SS2, WS_SS + SS_BYTES);
        DECL_WS(float, CS, WS_CS);
        DECL_WS(bf16, KB, WS_KB);
        DECL_WS(bf16, VB, WS_VB);
        DECL_WS(bf16, QB, WS_QB);
        DECL_WS(bf16, KS, WS_KS);
        DECL_WS(bf16, VS, WS_VS);

        pg8::Gemm g{XB, WQKV, R, 3 * D, D, XBS, XBS, 1 << 30, 0}; pg8::StaticOrder S; S.init(R, 3 * D, G, bx);
        pg8::EpiQKV E{SS2, CS, out + OFF_K_P, out + OFF_K_S, out + OFF_V_P, out + OFF_V_S, KB, VB, QB, KS, VS};
        pg8::gemm_phase<pg8::EpiQKV, pg8::StaticOrder, true, true>(ldsp + RING_OFF, g, S, E, tid);
        { DECL_IN(cache_k, 4); DECL_IN(cache_v, 5); DECL_WS(bf16, KS_f, WS_KS); DECL_WS(bf16, VS_f, WS_VS); conv_filler(cache_k, cache_v, KS_f, VS_f, (R / 256) * (3 * D / 256), G, bx, 106, 128, tid); }
    }
    SEAM(6);
    if (IN(7)) for (int rep_ = 0; rep_ < NREP(7); ++rep_) {
        if (rep_) xcd_barrier(bar);
        const CAS Args* const ap_ = ARGP(); float* const out = ap_->out; unsigned char* const ws = ap_->ws; (void)out; (void)ws;
        DECL_WS(bf16, QB, WS_QB);
        DECL_WS(bf16, KB, WS_KB);
        DECL_WS(bf16, VB, WS_VB);
        DECL_WS(bf16, KS, WS_KS);
        DECL_WS(bf16, VS, WS_VS);
        DECL_WS(bf16, O0, WS_O0);
        DECL_WS(bf16, O1, WS_O1);

        for (int u = vcu; u < 256; u += G) {
            const int b = u >> 4, h = (u >> 1) & 7, c = u & 1;
            const att::bf16* Qp = (const att::bf16*)QB + ((size_t)(RP + b * 16)) * D + h * 256 + c * 128;
            const att::bf16* Kp = (const att::bf16*)KS + (size_t)((b * 8 + h) * 2 + c) * SKEYS * 128;
            const att::bf16* Vp = (const att::bf16*)VS + (size_t)(b * 8 + h) * SKEYS * 256;
            att::bf16* Op = (att::bf16*)(c ? O1 : O0) + ((size_t)(RP + b * 16)) * D + h * 256;
            int nt_ = 65, sl_ = SLIM; asm volatile("" : "+s"(nt_), "+s"(sl_));
            att2::attn256<true>(Qp, Kp, Vp, Op, nt_, sl_, ldsp + RING_OFF, (char*)lds + RING_OFF, tid);
        }
        for (int it = 0; ; ++it) {
            const int p = vcu + G * (it >> 1); if (p >= 1024) break;
            const int combo = p >> 5, j = p & 31, qb = (it & 1) ? j : 63 - j;
            const int b = combo >> 4, h = (combo >> 1) & 7, c = combo & 1;
            const att::bf16* Qp = (const att::bf16*)QB + ((size_t)b * T + qb * 256) * D + h * 256 + c * 128;
            const att::bf16* Kp = (const att::bf16*)KB + (size_t)((b * 8 + h) * 2 + c) * T * 128;
            const att::bf16* Vp = (const att::bf16*)VB + (size_t)(b * 8 + h) * T * 256;
            att::bf16* Op = (att::bf16*)(c ? O1 : O0) + ((size_t)b * T + qb * 256) * D + h * 256;
            att2::attn256<false>(Qp, Kp, Vp, Op, 4 * qb + 4, qb * 256 + 64, ldsp + RING_OFF, (char*)lds + RING_OFF, tid);
        }
    }
    SEAM(7);
    if (IN(8)) for (int rep_ = 0; rep_ < NREP(8); ++rep_) {
        if (rep_) xcd_barrier(bar);
        const CAS Args* const ap_ = ARGP(); float* const out = ap_->out; unsigned char* const ws = ap_->ws; (void)out; (void)ws;
        DECL_IN(lam_q1, 13);
        DECL_IN(lam_k1, 14);
        DECL_IN(lam_q2, 15);
        DECL_IN(lam_k2, 16);
        DECL_WS(bf16, O0, WS_O0);
        DECL_WS(bf16, O1, WS_O1);
        DECL_WS(bf16, AO, WS_AO);

        float d1 = lam_q1[lane] * lam_k1[lane] + lam_q1[lane + 64] * lam_k1[lane + 64];
        float d2 = lam_q2[lane] * lam_k2[lane] + lam_q2[lane + 64] * lam_k2[lane + 64];
        d1 = wave_sum(d1); d2 = wave_sum(d2);
        const float lam = expf(d1) - expf(d2) + LAM_INIT;
        for (int r = gw; r < R; r += NGW) {
            const bf16* p0 = O0 + (size_t)r * D + 4 * lane; const bf16* p1 = O1 + (size_t)r * D + 4 * lane; bf16* po = AO + (size_t)r * XBS + 4 * lane;
#pragma unroll
            for (int h = 0; h < 8; ++h) {
                const unsigned long long a = *(const unsigned long long*)(p0 + h * 256), bq = *(const unsigned long long*)(p1 + h * 256);
                const unsigned a0 = (unsigned)a, a1 = (unsigned)(a >> 32), b0 = (unsigned)bq, b1 = (unsigned)(bq >> 32);
                const float o0 = pg8::bf_lo(a0) - lam * pg8::bf_lo(b0), o1 = pg8::bf_hi(a0) - lam * pg8::bf_hi(b0), o2 = pg8::bf_lo(a1) - lam * pg8::bf_lo(b1), o3 = pg8::bf_hi(a1) - lam * pg8::bf_hi(b1);
                const float ssq = wave_sum((o0 * o0 + o1 * o1) + (o2 * o2 + o3 * o3));
                const float rn = rsqrtf(ssq * (1.0f / 256.0f) + EPS);
                *(unsigned long long*)(po + h * 256) = (unsigned long long)pk2(o0 * rn, o1 * rn) | ((unsigned long long)pk2(o2 * rn, o3 * rn) << 32);
            }
        }
    }
    SEAM(8);
    if (IN(9)) for (int rep_ = 0; rep_ < NREP(9); ++rep_) {
        if (rep_) xcd_barrier(bar);
        const CAS Args* const ap_ = ARGP(); float* const out = ap_->out; unsigned char* const ws = ap_->ws; (void)out; (void)ws;
        DECL_WS(bf16, AO, WS_AO);
        DECL_WS(bf16, WO, WS_WO);
        DECL_WS(float, XA, WS_XA);
        DECL_WS(bf16, XB, WS_XB);
        DECL_WS(float, SS3, WS_SS + 2 * SS_BYTES);

        pg8::Gemm g{AO, WO, R, D, D, XBS, XBS, 1 << 30, 0}; pg8::StaticOrder S; S.init(R, D, G, bx);
        pg8::EpiResid E{XA, XA + (size_t)RP * D, XA, XB, SS3};
        pg8::gemm_phase<pg8::EpiResid, pg8::StaticOrder, true, true>(ldsp + RING_OFF, g, S, E, tid);
    }
    SEAM(9);
    if (IN(10)) for (int rep_ = 0; rep_ < NREP(10); ++rep_) {
        if (rep_) xcd_barrier(bar);
        const CAS Args* const ap_ = ARGP(); float* const out = ap_->out; unsigned char* const ws = ap_->ws; (void)out; (void)ws;
        DECL_WS(bf16, XB, WS_XB);
        DECL_WS(float, SS3, WS_SS + 2 * SS_BYTES);
        DECL_WS(bf16, GB, WS_GB);

        pg8::Gemm g{XB, (const bf16*)(ws + WS_WG0 + 3 * WS_WSTEP), R, FF, D, XBS, XBS, 1 << 30, 0}; pg8::StaticOrder S; S.init(R, FF, G, bx);
        pg8::EpiGate E{SS3, GB, out + OFF_FS_P + 2 * 2 * FF, out + OFF_FS_S + 16 * 2 * FF};
        pg8::gemm_phase<pg8::EpiGate, pg8::StaticOrder, true, true>(ldsp + RING_OFF, g, S, E, tid);
    }
    SEAM(10);
    if (IN(11)) for (int rep_ = 0; rep_ < NREP(11); ++rep_) {
        if (rep_) xcd_barrier(bar);
        const CAS Args* const ap_ = ARGP(); float* const out = ap_->out; unsigned char* const ws = ap_->ws; (void)out; (void)ws;
        DECL_IN(conv_w, 22);
        DECL_IN(conv_b, 23);
        DECL_IN(cache_ffn, 3);
        DECL_WS(bf16, XB, WS_XB);
        DECL_WS(float, SS3, WS_SS + 2 * SS_BYTES);
        DECL_WS(bf16, GB, WS_GB);
        DECL_WS(bf16, HB, WS_HB);

        pg8::Gemm g{XB, (const bf16*)(ws + WS_WG0 + 4 * WS_WSTEP), R, FF, D, XBS, XBS, 1 << 30, 0}; pg8::StaticOrder S; S.init(R, FF, G, bx);
        pg8::EpiUp E{SS3, GB, HB, conv_w + 3 * FF, conv_b + FF, cache_ffn + 16 * 2 * FF};
        pg8::gemm_phase<pg8::EpiUp, pg8::StaticOrder, true, true>(ldsp + RING_OFF, g, S, E, tid);
    }
    SEAM(11);
    if (IN(12)) for (int rep_ = 0; rep_ < NREP(12); ++rep_) {
        if (rep_) xcd_barrier(bar);
        const CAS Args* const ap_ = ARGP(); float* const out = ap_->out; unsigned char* const ws = ap_->ws; (void)out; (void)ws;
        DECL_WS(bf16, HB, WS_HB);
        DECL_WS(float, XA, WS_XA);
        DECL_WS(float, SS4, WS_SS + 3 * SS_BYTES);

        pg8::Gemm g{HB, (const bf16*)(ws + WS_WG0 + 5 * WS_WSTEP), R, D, FF, FFS, FFS, 1 << 30, 0}; pg8::StaticOrder S; S.init(R, D, G, bx);
        pg8::EpiResid E{XA, XA + (size_t)RP * D, XA, nullptr, SS4};
        pg8::gemm_phase<pg8::EpiResid, pg8::StaticOrder, true, true>(ldsp + RING_OFF, g, S, E, tid);
    }
    SEAM(12);
    if (IN(13)) for (int rep_ = 0; rep_ < NREP(13); ++rep_) {
        if (rep_) xcd_barrier(bar);
        const CAS Args* const ap_ = ARGP(); float* const out = ap_->out; unsigned char* const ws = ap_->ws; (void)out; (void)ws;
        DECL_IN(norm_final, 25);
        DECL_WS(float, XA, WS_XA);
        DECL_WS(float, SS4, WS_SS + 3 * SS_BYTES);

        for (int r = gw; r < R; r += NGW) {
            const float ri = rsqrtf(SS4[r] * (1.0f / D) + EPS);
            const float* src = XA + (size_t)r * D; float* dst = (r < RP) ? out + OFF_Y_P + (size_t)r * D : out + OFF_Y_S + (size_t)(r - RP) * D;
#pragma unroll
            for (int j = 0; j < 8; ++j) { const int cidx = 4 * lane + 256 * j; const f32x4 v = *(const f32x4*)(src + cidx); const f32x4 gq = *(const f32x4*)(norm_final + cidx); *(f32x4*)(dst + cidx) = v * ri * gq; }
        }
    }
#undef IN
#undef SEAM
#undef tid
#undef lane
}

extern "C" void kernel_launch(void* const* d_in, const int* in_sizes, int n_in, void* d_out, int out_size, void* d_ws, size_t ws_size, hipStream_t stream) {
    static int grid = 0;
    if (grid == 0) {
        if (n_in != 26 || in_sizes[0] != RP * D || (size_t)out_size != OUT_TOTAL || ws_size < WS_END) {
            fprintf(stderr, "kernel_launch: shape mismatch: n_in %d in0 %d out %d ws %zu (need %zu)\n", n_in, n_in > 0 ? in_sizes[0] : -1, out_size, ws_size, (size_t)WS_END); grid = -1; return; }
        int dev = 0, cus = 0, per_cu = 0;
        if (hipGetDevice(&dev) != hipSuccess || hipDeviceGetAttribute(&cus, hipDeviceAttributeMultiprocessorCount, dev) != hipSuccess) { grid = -1; return; }
        if (hipFuncSetAttribute((const void*)yoco_fwd, hipFuncAttributeMaxDynamicSharedMemorySize, LDS_BYTES) != hipSuccess) { fprintf(stderr, "kernel_launch: hipFuncSetAttribute failed\n"); grid = -1; return; }
        if (hipOccupancyMaxActiveBlocksPerMultiprocessor(&per_cu, (const void*)yoco_fwd, NWAVES * 64, LDS_BYTES) != hipSuccess || per_cu < 1)
            fprintf(stderr, "kernel_launch: occupancy query reports %d\n", per_cu);
        (void)hipGetLastError();
        grid = cus;
    }
    if (grid < 0) return;
    if (hipMemsetAsync((char*)d_ws + WS_CTL, 0, CTL_ZERO_BYTES, stream) != hipSuccess) { fprintf(stderr, "kernel_launch: memset failed\n"); return; }
    Args a{};
    for (int i = 0; i < 26; ++i) a.in[i] = (const float*)d_in[i];
    a.out = (float*)d_out; a.ws = (unsigned char*)d_ws;
#if MK_PER_PHASE
    for (int ph = 0; ph < NPHASE; ++ph) { a.ph_lo = ph; a.ph_hi = ph + 1; hipLaunchKernelGGL(yoco_fwd, dim3(grid), dim3(NWAVES * 64), LDS_BYTES, stream, a); }
#else
    a.ph_lo = 0; a.ph_hi = NPHASE; hipLaunchKernelGGL(yoco_fwd, dim3(grid), dim3(NWAVES * 64), LDS_BYTES, stream, a);
#endif
    const hipError_t le = hipPeekAtLastError();
    if (le != hipSuccess) fprintf(stderr, "kernel_launch: launch failed: %s\n", hipGetErrorName(le));
}
```
